# Optimizing an MI355X kernel written in HIP

```python
import jax, jax.numpy as jnp
from jax import lax
import numpy as np

D_MODEL = 1024
BATCH = 4
SEQ = 8192
DEPTH = 1
DEC_BATCH = 32
DEC_SEQ = 1
PAST_LEN = 16384
PAGE_SIZE = 128

N_HEADS = 8
HEAD_DIM = 64
N_KV = 2
GROUP = N_HEADS // N_KV
CMP_LEN = 32
CMP_STRIDE = 16
CMP_SUB = CMP_LEN // CMP_STRIDE
CMP_HIDDEN = 128
SEL_BLOCK = 64
CMP_RATIO = SEL_BLOCK // CMP_STRIDE
CMP_OVER = CMP_SUB - 1
SEL_TOP = 16
WINDOW = 512
Q_BLOCK = 128
FORCE_SCORE = 1e4
D_B = 512
N_GROUPS_B = 4
GROUP_CH = D_B // N_GROUPS_B
CHUNK = 128
D_FF = 2816
ALPHA = (2.0 * DEPTH) ** 0.25
BETA = (8.0 * DEPTH) ** -0.25
LN_EPS = 1e-5
NEG_INF = -1e30
Q_W = N_HEADS * HEAD_DIM
KV_W = N_KV * HEAD_DIM
GATE_W = N_HEADS * 3
IN_W = Q_W + 6 * KV_W + GATE_W + 2 * D_B + 2 * D_MODEL

kernel_name = 'nsa_gmlp_macaron_deepnorm_step'


def layer_norm(x, g, b):
    xf = x.astype(jnp.float32)
    mu = jnp.mean(xf, axis=-1, keepdims=True)
    var = jnp.mean(jnp.square(xf - mu), axis=-1, keepdims=True)
    return ((xf - mu) * lax.rsqrt(var + LN_EPS) * g + b).astype(x.dtype)


def swiglu(x, w_in, w_out):
    gate, up = jnp.split(x @ w_in, 2, axis=-1)
    return (jax.nn.silu(gate) * up) @ w_out


def half_ffn_block(x, w_in, w_out, g, b):
    return layer_norm(ALPHA * x + 0.5 * swiglu(x, w_in, w_out), g, b)


def alibi_slopes():
    h = jnp.arange(1, N_HEADS + 1, dtype=jnp.float32)
    return jnp.exp2(-8.0 * h / N_HEADS).reshape(N_KV, GROUP)


def masked_softmax(s, mask):
    s = jnp.where(mask, s.astype(jnp.float32), NEG_INF)
    return jnp.where(mask, jax.nn.softmax(s, axis=-1), 0.0)


def mixer_inputs(h, w_in):
    B, T = h.shape[0], h.shape[1]
    sizes = (Q_W,) + (KV_W,) * 6 + (GATE_W, D_B, D_B, D_MODEL, D_MODEL)
    cuts = np.cumsum(sizes)[:-1].tolist()
    q, kc, vc, ks, vs, kw, vw, g, u, v, ga, gb = jnp.split(h @ w_in, cuts, axis=-1)
    kv = lambda a: a.reshape(B, T, N_KV, HEAD_DIM)
    q = q.reshape(B, T, N_KV, GROUP, HEAD_DIM) * (HEAD_DIM ** -0.5)
    gates = jax.nn.sigmoid(g.reshape(B, T, N_KV, GROUP, 3))
    return (q, gates, kv(kc), kv(vc), kv(ks), kv(vs), kv(kw), kv(vw),
            jax.nn.gelu(u), jax.nn.gelu(v), ga, gb)


def compress(k, pe, w1, w2):
    B, T = k.shape[0], k.shape[1]
    ns = T // CMP_STRIDE
    nc = ns - CMP_SUB + 1
    sub = k.reshape(B, ns, CMP_STRIDE, N_KV, HEAD_DIM).transpose(0, 1, 3, 2, 4)
    sub = sub.reshape(B, ns, N_KV, CMP_STRIDE * HEAD_DIM)
    w1p = w1.reshape(CMP_SUB, CMP_STRIDE * HEAD_DIM, CMP_HIDDEN)
    hid = sub[:, :nc] @ w1p[0]
    for i in range(1, CMP_SUB):
        hid = hid + sub[:, i:i + nc] @ w1p[i]
    hid = hid + pe.reshape(-1) @ w1
    return jax.nn.gelu(hid) @ w2


def cmp_end_positions(nc):
    return jnp.arange(nc, dtype=jnp.int32) * CMP_STRIDE + (CMP_LEN - 1)


def sel_blocks(k):
    B, T = k.shape[0], k.shape[1]
    return k.reshape(B, T // SEL_BLOCK, SEL_BLOCK, N_KV, HEAD_DIM).transpose(0, 3, 1, 2, 4)


def block_importance(imp, nsel):
    nc = imp.shape[-1]
    total = CMP_RATIO * nsel + CMP_OVER
    pad = [(0, 0)] * (imp.ndim - 1) + [(CMP_OVER, total - CMP_OVER - nc)]
    P = jnp.pad(imp, pad)
    out = P[..., 0:CMP_RATIO * nsel:CMP_RATIO]
    for o in range(1, CMP_RATIO + CMP_OVER):
        out = out + P[..., o:o + CMP_RATIO * nsel:CMP_RATIO]
    return out


def nsa_block(q, gates, qpos, kc, vc, c_end, kslb, vslb, kw, vw, wpos, slopes):
    B, Q = q.shape[0], q.shape[1]
    nsel = kslb.shape[2]
    dist_c = qpos[:, None] - c_end[None, :]
    s_c = jnp.einsum('bqgrd,bcgd->bqgrc', q, kc) - slopes[:, :, None] * dist_c[:, None, None, :]
    p_c = masked_softmax(s_c, (dist_c >= 0)[:, None, None, :])
    o_c = jnp.einsum('bqgrc,bcgd->bqgrd', p_c, vc)
    p_slc = block_importance(jnp.sum(p_c, axis=3), nsel)
    j = jnp.arange(nsel, dtype=jnp.int32)[None, :]
    cur = (qpos // SEL_BLOCK)[:, None]
    forced = (j == 0) | (j == cur) | (j == cur - 1)
    valid = (j * SEL_BLOCK) <= qpos[:, None]
    score = jnp.where(valid[None, :, None, :],
                      jnp.where(forced[None, :, None, :], FORCE_SCORE, p_slc), NEG_INF)
    _, idx = lax.top_k(score, min(SEL_TOP, nsel))
    bi = jnp.arange(B)[:, None, None, None]
    gi = jnp.arange(N_KV)[None, None, :, None]
    ks = kslb[bi, gi, idx]
    vs = vslb[bi, gi, idx]
    spos = idx[..., None] * SEL_BLOCK + jnp.arange(SEL_BLOCK, dtype=jnp.int32)
    dist_s = qpos[None, :, None, None, None] - spos
    s_s = jnp.einsum('bqgrd,bqgkjd->bqgrkj', q, ks) - slopes[None, None, :, :, None, None] * dist_s[:, :, :, None]
    mask_s = jnp.broadcast_to((dist_s >= 0)[:, :, :, None], s_s.shape)
    n_keys = idx.shape[-1] * SEL_BLOCK
    p_s = masked_softmax(s_s.reshape(B, Q, N_KV, GROUP, n_keys), mask_s.reshape(B, Q, N_KV, GROUP, n_keys))
    o_s = jnp.einsum('bqgrn,bqgnd->bqgrd', p_s, vs.reshape(B, Q, N_KV, n_keys, HEAD_DIM))
    dist_w = qpos[:, None] - wpos[None, :]
    mask_w = (dist_w >= 0) & (dist_w < WINDOW) & (wpos >= 0)[None, :]
    s_w = jnp.einsum('bqgrd,bwgd->bqgrw', q, kw) - slopes[:, :, None] * dist_w[:, None, None, :]
    p_w = masked_softmax(s_w, mask_w[:, None, None, :])
    o_w = jnp.einsum('bqgrw,bwgd->bqgrd', p_w, vw)
    o = gates[..., 0:1] * o_c + gates[..., 1:2] * o_s + gates[..., 2:3] * o_w
    return o.astype(q.dtype)


def nsa_prompt(q, gates, kcmp, vcmp, ksel, vsel, kwin, vwin, pe_k, w1_k, w2_k, pe_v, w1_v, w2_v, slopes):
    B, T = q.shape[0], q.shape[1]
    kc = compress(kcmp, pe_k, w1_k, w2_k)
    vc = compress(vcmp, pe_v, w1_v, w2_v)
    c_end = cmp_end_positions(kc.shape[1])
    kslb, vslb = sel_blocks(ksel), sel_blocks(vsel)
    pad = ((0, 0), (WINDOW, 0), (0, 0), (0, 0))
    kw_pad, vw_pad = jnp.pad(kwin, pad), jnp.pad(vwin, pad)
    nqb = T // Q_BLOCK
    qs = q.reshape(B, nqb, Q_BLOCK, N_KV, GROUP, HEAD_DIM).swapaxes(0, 1)
    gs = gates.reshape(B, nqb, Q_BLOCK, N_KV, GROUP, 3).swapaxes(0, 1)
    starts = jnp.arange(nqb, dtype=jnp.int32) * Q_BLOCK

    def one_block(args):
        qb, gb, s0 = args
        qpos = s0 + jnp.arange(Q_BLOCK, dtype=jnp.int32)
        kw = lax.dynamic_slice_in_dim(kw_pad, s0, WINDOW + Q_BLOCK, axis=1)
        vw = lax.dynamic_slice_in_dim(vw_pad, s0, WINDOW + Q_BLOCK, axis=1)
        wpos = s0 - WINDOW + jnp.arange(WINDOW + Q_BLOCK, dtype=jnp.int32)
        return nsa_block(qb, gb, qpos, kc, vc, c_end, kslb, vslb, kw, vw, wpos, slopes)

    o = lax.map(one_block, (qs, gs, starts))
    return o.swapaxes(0, 1).reshape(B, T, Q_W)


def paged_rows(pool, page_table):
    rows = pool[page_table]
    return rows.reshape(rows.shape[0], -1, N_KV, HEAD_DIM)


def nsa_sample(q, gates, kcmp, vcmp, ksel, vsel, kwin, vwin,
               cache_cmp_k, cache_cmp_v, cache_sel_k, cache_sel_v, cache_win_k, cache_win_v, page_table,
               pe_k, w1_k, w2_k, pe_v, w1_v, w2_v, slopes):
    B, n_new = q.shape[0], q.shape[1]
    past = page_table.shape[1] * PAGE_SIZE
    t_pad = -(-(past + n_new) // SEL_BLOCK) * SEL_BLOCK

    def full_rows(pool, new):
        rows = jnp.concatenate([paged_rows(pool, page_table), new], axis=1)
        return jnp.pad(rows, ((0, 0), (0, t_pad - rows.shape[1]), (0, 0), (0, 0)))

    kc = compress(full_rows(cache_cmp_k, kcmp), pe_k, w1_k, w2_k)
    vc = compress(full_rows(cache_cmp_v, vcmp), pe_v, w1_v, w2_v)
    c_end = cmp_end_positions(kc.shape[1])
    kslb = sel_blocks(full_rows(cache_sel_k, ksel))
    vslb = sel_blocks(full_rows(cache_sel_v, vsel))
    wbuf = cache_win_k.shape[1]
    kw = jnp.concatenate([cache_win_k, kwin], axis=1)
    vw = jnp.concatenate([cache_win_v, vwin], axis=1)
    wpos = past - wbuf + jnp.arange(wbuf + n_new, dtype=jnp.int32)
    qpos = past + jnp.arange(n_new, dtype=jnp.int32)
    o = nsa_block(q, gates, qpos, kc, vc, c_end, kslb, vslb, kw, vw, wpos, slopes)
    return o.reshape(B, n_new, Q_W), kw[:, -wbuf:], vw[:, -wbuf:]


def gmlp_mix(u, v, ln_g, ln_b, w_s, b_s):
    B, T = u.shape[0], u.shape[1]
    L = min(T, CHUNK)
    vn = layer_norm(v, ln_g, ln_b)
    vc = vn.reshape(B, T // L, L, N_GROUPS_B, GROUP_CH)
    w = jnp.tril(w_s[:, :L, :L])
    s = jnp.einsum('hst,bnthc->bnshc', w, vc) + b_s[:, :L].T[None, None, :, :, None]
    return u * s.reshape(B, T, D_B), vn


def merge_branches(o_a, z, ga, gb, w_branch_a, w_branch_b, w_out):
    return (jax.nn.sigmoid(ga) * (o_a @ w_branch_a) + jax.nn.sigmoid(gb) * (z @ w_branch_b)) @ w_out


def setup_inputs(seed: int = 0) -> dict:
    key = jax.random.key(seed)
    ks = jax.random.split(key, 40)
    nrm = lambda k, shape, scale: jax.random.normal(k, shape, jnp.float32) * scale
    n_pages = PAST_LEN // PAGE_SIZE
    n_used = DEC_BATCH * n_pages
    n_phys = n_used + (n_used + 3) // 4
    wbuf = min(WINDOW, PAST_LEN)
    pool = (n_phys, PAGE_SIZE, N_KV, HEAD_DIM)
    perm = jax.random.permutation(ks[9], n_phys).astype(jnp.int32)
    page_table = perm[:n_used].reshape(DEC_BATCH, n_pages)
    gain = lambda k, n: 1.0 + nrm(k, (n,), 0.02)
    return {
        'x_prompt': nrm(ks[0], (BATCH, SEQ, D_MODEL), 1.0),
        'x_sample': nrm(ks[1], (DEC_BATCH, DEC_SEQ, D_MODEL), 1.0),
        'cache_cmp_k': nrm(ks[2], pool, 1.0),
        'cache_cmp_v': nrm(ks[3], pool, 1.0),
        'cache_sel_k': nrm(ks[4], pool, 1.0),
        'cache_sel_v': nrm(ks[5], pool, 1.0),
        'cache_win_k': nrm(ks[6], (DEC_BATCH, wbuf, N_KV, HEAD_DIM), 1.0),
        'cache_win_v': nrm(ks[7], (DEC_BATCH, wbuf, N_KV, HEAD_DIM), 1.0),
        'page_table': page_table,
        'ffn1_w_in': nrm(ks[10], (D_MODEL, 2 * D_FF), D_MODEL ** -0.5),
        'ffn1_w_out': nrm(ks[11], (D_FF, D_MODEL), BETA * D_FF ** -0.5),
        'ln1_g': gain(ks[12], D_MODEL),
        'ln1_b': nrm(ks[13], (D_MODEL,), 0.02),
        'w_in': nrm(ks[14], (D_MODEL, IN_W), D_MODEL ** -0.5),
        'cmp_pe_k': nrm(ks[15], (CMP_LEN, HEAD_DIM), 0.02),
        'cmp_w1_k': nrm(ks[16], (CMP_LEN * HEAD_DIM, CMP_HIDDEN), (CMP_LEN * HEAD_DIM) ** -0.5),
        'cmp_w2_k': nrm(ks[17], (CMP_HIDDEN, HEAD_DIM), CMP_HIDDEN ** -0.5),
        'cmp_pe_v': nrm(ks[18], (CMP_LEN, HEAD_DIM), 0.02),
        'cmp_w1_v': nrm(ks[19], (CMP_LEN * HEAD_DIM, CMP_HIDDEN), (CMP_LEN * HEAD_DIM) ** -0.5),
        'cmp_w2_v': nrm(ks[20], (CMP_HIDDEN, HEAD_DIM), CMP_HIDDEN ** -0.5),
        'gmlp_ln_g': gain(ks[21], D_B),
        'gmlp_ln_b': nrm(ks[22], (D_B,), 0.02),
        'spatial_w': nrm(ks[23], (N_GROUPS_B, CHUNK, CHUNK), CHUNK ** -0.5),
        'spatial_b': 1.0 + nrm(ks[24], (N_GROUPS_B, CHUNK), 0.02),
        'w_branch_a': nrm(ks[25], (Q_W, D_MODEL), Q_W ** -0.5),
        'w_branch_b': nrm(ks[26], (D_B, D_MODEL), D_B ** -0.5),
        'w_out': nrm(ks[27], (D_MODEL, D_MODEL), BETA * D_MODEL ** -0.5),
        'ln2_g': gain(ks[28], D_MODEL),
        'ln2_b': nrm(ks[29], (D_MODEL,), 0.02),
        'ffn2_w_in': nrm(ks[30], (D_MODEL, 2 * D_FF), D_MODEL ** -0.5),
        'ffn2_w_out': nrm(ks[31], (D_FF, D_MODEL), BETA * D_FF ** -0.5),
        'ln3_g': gain(ks[32], D_MODEL),
        'ln3_b': nrm(ks[33], (D_MODEL,), 0.02),
    }


def reference(x_prompt, x_sample, cache_cmp_k, cache_cmp_v, cache_sel_k, cache_sel_v, cache_win_k, cache_win_v,
              page_table, ffn1_w_in, ffn1_w_out, ln1_g, ln1_b, w_in, cmp_pe_k, cmp_w1_k, cmp_w2_k,
              cmp_pe_v, cmp_w1_v, cmp_w2_v, gmlp_ln_g, gmlp_ln_b, spatial_w, spatial_b,
              w_branch_a, w_branch_b, w_out, ln2_g, ln2_b, ffn2_w_in, ffn2_w_out, ln3_g, ln3_b):
    slopes = alibi_slopes()
    for _ in range(DEPTH):
        h = half_ffn_block(x_prompt, ffn1_w_in, ffn1_w_out, ln1_g, ln1_b)
        (q, gates, kc, vc, ksl, vsl, kw, vw, u, v, ga, gb) = mixer_inputs(h, w_in)
        o_a = nsa_prompt(q, gates, kc, vc, ksl, vsl, kw, vw,
                         cmp_pe_k, cmp_w1_k, cmp_w2_k, cmp_pe_v, cmp_w1_v, cmp_w2_v, slopes)
        z, _ = gmlp_mix(u, v, gmlp_ln_g, gmlp_ln_b, spatial_w, spatial_b)
        h = layer_norm(ALPHA * h + merge_branches(o_a, z, ga, gb, w_branch_a, w_branch_b, w_out), ln2_g, ln2_b)
        y_prompt = half_ffn_block(h, ffn2_w_in, ffn2_w_out, ln3_g, ln3_b)
        wkeep = min(WINDOW, kw.shape[1])
        p_cmp_k, p_cmp_v, p_sel_k, p_sel_v = kc, vc, ksl, vsl
        p_win_k, p_win_v = kw[:, -wkeep:], vw[:, -wkeep:]
        hs = half_ffn_block(x_sample, ffn1_w_in, ffn1_w_out, ln1_g, ln1_b)
        (qs, gates_s, kcs, vcs, ksls, vsls, kws, vws, us, vs_, gas, gbs) = mixer_inputs(hs, w_in)
        o_as, s_win_k, s_win_v = nsa_sample(qs, gates_s, kcs, vcs, ksls, vsls, kws, vws,
                                             cache_cmp_k, cache_cmp_v, cache_sel_k, cache_sel_v,
                                             cache_win_k, cache_win_v, page_table,
                                             cmp_pe_k, cmp_w1_k, cmp_w2_k, cmp_pe_v, cmp_w1_v, cmp_w2_v, slopes)
        zs, s_chunk_v = gmlp_mix(us, vs_, gmlp_ln_g, gmlp_ln_b, spatial_w, spatial_b)
        hs = layer_norm(ALPHA * hs + merge_branches(o_as, zs, gas, gbs, w_branch_a, w_branch_b, w_out), ln2_g, ln2_b)
        y_sample = half_ffn_block(hs, ffn2_w_in, ffn2_w_out, ln3_g, ln3_b)
    return (y_prompt, y_sample, p_cmp_k, p_cmp_v, p_sel_k, p_sel_v, p_win_k, p_win_v,
            kcs, vcs, ksls, vsls, s_win_k, s_win_v, s_chunk_v)
```

```cpp
#include <hip/hip_runtime.h>
#include <cstdio>
#include <cstdint>
namespace pg8 {
#define PG8_LAS __attribute__((address_space(3)))
typedef unsigned short bf16_t;
typedef short bf16x8 __attribute__((ext_vector_type(8)));
typedef float f32x4 __attribute__((ext_vector_type(4)));
typedef unsigned u32x4 __attribute__((ext_vector_type(4)));
constexpr int BM = 256, BK = 64, HALF = 128, HTB = HALF * BK * 2  , STAGE_BYTES = 8 * HTB, NXCD = 8, WGM = 8;

__host__ __device__ __forceinline__ int lds_byte(int r, int c) { const int st = (r >> 4) * 2 + (c >> 5), rr = r & 15, cc = c & 31, ob = rr * 64 + cc * 2; return st * 1024 + (ob ^ (((ob >> 9) & 1) << 5)); }
__host__ __device__ __forceinline__ void stage_rc(int b, int& R, int& C) { const int st = b / 1024, sb = b % 1024, swz = sb ^ (((sb >> 9) & 1) << 5); R = (st >> 1) * 16 + swz / 64; C = (st & 1) * 32 + (swz % 64) / 2; }
__host__ __device__ __forceinline__ int perm32(int rho) { const int n = rho >> 4, i = rho & 15; return 8 * (i >> 2) + 4 * n + (i & 3); }

struct Unit { int pm, pn; };
struct Gemm { const bf16_t* A; const bf16_t* Bt; int lda, ldb, nt; };

struct StaticOrder {
    int nM, nN, nwg, G, c;
    __host__ __device__ void init(int nM_, int nN_, int G_, int c_) { nM = nM_; nN = nN_; nwg = nM * nN; G = G_; c = c_; }
    __host__ __device__ bool next(int i, Unit& u) const {
        const long L = (long)i * G + c; if (L >= nwg) return false;
        int wgid = (int)L; { const int q = nwg / NXCD, r = nwg % NXCD, xcd = wgid % NXCD, off = wgid / NXCD; wgid = (xcd < r ? xcd * (q + 1) : r * (q + 1) + (xcd - r) * q) + off; }
        const int nig = WGM * nN, gid = wgid / nig, fm = gid * WGM, gsz = (nM - fm) < WGM ? (nM - fm) : WGM;
        u.pm = fm + ((wgid % nig) % gsz); u.pn = (wgid % nig) / gsz; return true;
    }
};

__device__ __forceinline__ unsigned cvt_pk_bf16(float lo, float hi) { unsigned r; asm volatile("v_cvt_pk_bf16_f32 %0, %1, %2" : "=v"(r) : "v"(lo), "v"(hi)); return r; }

template <class Epi, class Sched, bool ALIGN_EPI = false, bool SP2 = false>
__device__ __forceinline__ void gemm_phase(PG8_LAS unsigned char* lds, const Gemm g, const Sched& S, const Epi& E) {
    const int tid = threadIdx.x, wid = __builtin_amdgcn_readfirstlane(tid >> 6), lane = tid & 63, wr = wid >> 2, wc = wid & 3, fr = lane & 15, fq = lane >> 4;
    const int nt = g.nt;
    unsigned voffA[2], voffB[2];
#pragma unroll
    for (int i = 0; i < 2; ++i) { int R, C; stage_rc(tid * 16 + i * 8192, R, C); const int Rb = Epi::PERM ? ((R & ~31) + perm32(R & 31)) : R;
        voffA[i] = (unsigned)(R * g.lda + C) * 2u; voffB[i] = (unsigned)(Rb * g.ldb + C) * 2u; }
    const size_t kstep = (size_t)(BK * 2);
    const size_t hstepA = (size_t)HALF * g.lda * 2, hstepB = (size_t)HALF * g.ldb * 2;
    const size_t tstepA = 2 * hstepA, tstepB = 2 * hstepB;
    const unsigned ldsw = (unsigned)wid * 1024u;
    const int aoff = lds_byte(wr * 64 + fr, fq * 8), boff = lds_byte(wc * 32 + fr, fq * 8);
#define PG8_SA(b, h) (((b) * 2 + (h)) * HTB)
#define PG8_SB(b, h) ((4 + (b) * 2 + (h)) * HTB)
#define PG8_STAGE(bufoff, gbase, voff) do { _Pragma("unroll") for (int _i = 0; _i < 2; ++_i) \
        __builtin_amdgcn_global_load_lds((const unsigned*)((const char*)(gbase) + (voff)[_i]), (PG8_LAS unsigned*)(lds + (bufoff) + ldsw + _i * 8192), 16, 0, 0); } while (0)
#define PG8_LDA(dst, b, h) do { _Pragma("unroll") for (int m = 0; m < 4; ++m) _Pragma("unroll") for (int k = 0; k < 2; ++k) dst[m][k] = *(const PG8_LAS bf16x8*)(lds + PG8_SA(b, h) + aoff + m * 2048 + k * 1024); } while (0)
#define PG8_LDB(dst, b, h) do { _Pragma("unroll") for (int n = 0; n < 2; ++n) _Pragma("unroll") for (int k = 0; k < 2; ++k) dst[n][k] = *(const PG8_LAS bf16x8*)(lds + PG8_SB(b, h) + boff + n * 2048 + k * 1024); } while (0)
#define PG8_MMA(ai, bj, At, Bt) do { __builtin_amdgcn_s_setprio(1); _Pragma("unroll") for (int m = 0; m < 4; ++m) _Pragma("unroll") for (int n = 0; n < 2; ++n) _Pragma("unroll") for (int k = 0; k < 2; ++k) \
        acc[ai][bj][m][n] = __builtin_amdgcn_mfma_f32_16x16x32_bf16(Bt[n][k], At[m][k], acc[ai][bj][m][n], 0, 0, 0); __builtin_amdgcn_s_setprio(0); } while (0)
#define PG8_WAIT_V(n) asm volatile("s_waitcnt vmcnt(" #n ")" ::: "memory")
#define PG8_WAIT_L(n) asm volatile("s_waitcnt lgkmcnt(" #n ")" ::: "memory")
#define PG8_BAR __builtin_amdgcn_s_barrier()
#define PG8_SCHED __builtin_amdgcn_sched_barrier(0)
    Unit cur, nxt; int ui = 0;
    if (!S.next(0, cur)) return;
    f32x4 acc[2][2][4][2];
#pragma unroll
    for (int a = 0; a < 2; ++a)
#pragma unroll
        for (int b = 0; b < 2; ++b)
#pragma unroll
            for (int m = 0; m < 4; ++m)
#pragma unroll
                for (int n = 0; n < 2; ++n) acc[a][b][m][n] = (f32x4){0.f, 0.f, 0.f, 0.f};
    bf16x8 At[4][2], B0[2][2], B1[2][2];
    const char* cA = (const char*)g.A + (size_t)cur.pm * tstepA; const char* cB = (const char*)g.Bt + (size_t)cur.pn * tstepB;
    if constexpr (SP2) {
        PG8_STAGE(PG8_SB(0, 0), cB, voffB); PG8_STAGE(PG8_SB(0, 1), cB + hstepB, voffB); PG8_STAGE(PG8_SA(0, 0), cA, voffA); PG8_STAGE(PG8_SA(0, 1), cA + hstepA, voffA);
        if (wr == 1) PG8_BAR;
        PG8_WAIT_V(2); PG8_BAR;
        PG8_STAGE(PG8_SB(1, 0), cB + kstep, voffB); PG8_STAGE(PG8_SA(1, 0), cA + kstep, voffA); PG8_STAGE(PG8_SB(1, 1), cB + hstepB + kstep, voffB);
        PG8_WAIT_V(6); PG8_BAR;
    } else {
        PG8_STAGE(PG8_SB(0, 0), cB, voffB); PG8_STAGE(PG8_SA(0, 0), cA, voffA); PG8_STAGE(PG8_SB(0, 1), cB + hstepB, voffB); PG8_STAGE(PG8_SA(0, 1), cA + hstepA, voffA);
        if (wr == 1) PG8_BAR;
        PG8_WAIT_V(4); PG8_BAR;
        PG8_STAGE(PG8_SB(1, 0), cB + kstep, voffB); PG8_STAGE(PG8_SA(1, 0), cA + kstep, voffA); PG8_STAGE(PG8_SB(1, 1), cB + hstepB + kstep, voffB);
        PG8_WAIT_V(6); PG8_BAR;
    }
    for (;;) {
        const bool has_next = S.next(ui + 1, nxt);
        const char* nA = has_next ? (const char*)g.A + (size_t)nxt.pm * tstepA : cA; const char* nB = has_next ? (const char*)g.Bt + (size_t)nxt.pn * tstepB : cB;
        for (int t = 0; t < nt; t += 2) {
            const bool last = (t == nt - 2);
            const char* a1 = cA + (size_t)(t + 1) * kstep;
            const char* a2 = last ? nA : cA + (size_t)(t + 2) * kstep; const char* b2 = last ? nB : cB + (size_t)(t + 2) * kstep;
            const char* a3 = a2 + kstep; const char* b3 = b2 + kstep;
            if constexpr (Epi::MIDK) { if (t == (nt >> 1)) E.mid(acc, cur, wr, wc, fr, fq); }
            if constexpr (SP2) {
            PG8_LDB(B0, 0, 0); PG8_LDB(B1, 0, 1); PG8_SCHED; PG8_LDA(At, 0, 0); PG8_STAGE(PG8_SA(1, 1), a1 + hstepA, voffA);
            PG8_WAIT_V(8); PG8_WAIT_L(0); PG8_BAR; PG8_MMA(0, 0, At, B0); PG8_MMA(0, 1, At, B1); PG8_BAR; PG8_SCHED;
            PG8_LDA(At, 0, 1); PG8_STAGE(PG8_SB(0, 0), b2, voffB); PG8_STAGE(PG8_SB(0, 1), b2 + hstepB, voffB); PG8_STAGE(PG8_SA(0, 0), a2, voffA);
            PG8_WAIT_V(8); PG8_WAIT_L(0); PG8_BAR; PG8_MMA(1, 0, At, B0); PG8_MMA(1, 1, At, B1); PG8_BAR; PG8_SCHED;
            PG8_LDB(B0, 1, 0); PG8_LDB(B1, 1, 1); PG8_SCHED; PG8_LDA(At, 1, 0); PG8_STAGE(PG8_SA(0, 1), a2 + hstepA, voffA);
            PG8_WAIT_V(8); PG8_WAIT_L(0); PG8_BAR; PG8_MMA(0, 0, At, B0); PG8_MMA(0, 1, At, B1); PG8_BAR; PG8_SCHED;
            PG8_LDA(At, 1, 1); PG8_STAGE(PG8_SB(1, 0), b3, voffB); PG8_STAGE(PG8_SB(1, 1), b3 + hstepB, voffB); PG8_STAGE(PG8_SA(1, 0), a3, voffA);
            PG8_WAIT_V(8); PG8_WAIT_L(0); PG8_BAR; PG8_MMA(1, 0, At, B0); PG8_MMA(1, 1, At, B1); PG8_BAR; PG8_SCHED;
            } else {
            PG8_LDB(B0, 0, 0); PG8_SCHED; PG8_LDA(At, 0, 0); PG8_STAGE(PG8_SA(1, 1), a1 + hstepA, voffA);
            PG8_WAIT_L(8); PG8_BAR; PG8_WAIT_L(0); PG8_MMA(0, 0, At, B0); PG8_BAR; PG8_SCHED;
            PG8_LDB(B1, 0, 1); PG8_STAGE(PG8_SB(0, 0), b2, voffB);
            PG8_BAR; PG8_WAIT_L(0); PG8_MMA(0, 1, At, B1); PG8_BAR;
            PG8_LDA(At, 0, 1); PG8_STAGE(PG8_SA(0, 0), a2, voffA);
            PG8_BAR; PG8_WAIT_L(0); PG8_MMA(1, 0, At, B0); PG8_BAR; PG8_SCHED;
            PG8_STAGE(PG8_SB(0, 1), b2 + hstepB, voffB);
            PG8_WAIT_V(6); PG8_BAR; PG8_MMA(1, 1, At, B1); PG8_BAR;
            PG8_LDB(B0, 1, 0); PG8_SCHED; PG8_LDA(At, 1, 0); PG8_STAGE(PG8_SA(0, 1), a2 + hstepA, voffA);
            PG8_WAIT_L(8); PG8_BAR; PG8_WAIT_L(0); PG8_MMA(0, 0, At, B0); PG8_BAR; PG8_SCHED;
            PG8_LDB(B1, 1, 1); PG8_STAGE(PG8_SB(1, 0), b3, voffB);
            PG8_BAR; PG8_WAIT_L(0); PG8_MMA(0, 1, At, B1); PG8_BAR;
            PG8_LDA(At, 1, 1); PG8_STAGE(PG8_SA(1, 0), a3, voffA);
            PG8_BAR; PG8_WAIT_L(0); PG8_MMA(1, 0, At, B0); PG8_BAR; PG8_SCHED;
            PG8_STAGE(PG8_SB(1, 1), b3 + hstepB, voffB);
            PG8_WAIT_V(6); PG8_BAR; PG8_MMA(1, 1, At, B1); PG8_BAR;
            }
        }
        if constexpr (ALIGN_EPI) { if (wr == 0) PG8_BAR; }
        E(acc, cur, wr, wc, fr, fq);
        if (!has_next) break;
#pragma unroll
        for (int a = 0; a < 2; ++a)
#pragma unroll
            for (int b = 0; b < 2; ++b)
#pragma unroll
                for (int m = 0; m < 4; ++m)
#pragma unroll
                    for (int n = 0; n < 2; ++n) acc[a][b][m][n] = (f32x4){0.f, 0.f, 0.f, 0.f};
        cur = nxt; cA = nA; cB = nB; ++ui;
        if constexpr (ALIGN_EPI) { if (wr == 1) PG8_BAR; }
    }
    PG8_WAIT_V(0);
    if constexpr (!ALIGN_EPI) { if (wr == 0) PG8_BAR; }
    PG8_BAR;
#undef PG8_SA
#undef PG8_SB
#undef PG8_STAGE
#undef PG8_LDA
#undef PG8_LDB
#undef PG8_MMA
#undef PG8_WAIT_V
#undef PG8_WAIT_L
#undef PG8_BAR
#undef PG8_SCHED
}
}
constexpr int NWAVES = 8;
constexpr int DM = 1024, MP = 32768, MS = 32, MR = MP + 256, TSEQ = 8192, NB = 4;
constexpr int FF = 2816, NFF2 = 2 * FF, NPROJ = 4608, DB = 512, QW = 512;
constexpr int PASTL = 16384, NPAGE = 128;
constexpr float ALPHA = 1.189207115002721f;
constexpr float LN_EPS = 1e-5f;
constexpr size_t O_Y = 0, O_YS = O_Y + (size_t)MP * DM, O_PCK = O_YS + (size_t)MS * DM, O_PCV = O_PCK + (size_t)MP * 128, O_PSK = O_PCV + (size_t)MP * 128, O_PSV = O_PSK + (size_t)MP * 128,
                 O_PWK = O_PSV + (size_t)MP * 128, O_PWV = O_PWK + (size_t)NB * 512 * 128, O_SCK = O_PWV + (size_t)NB * 512 * 128, O_SCV = O_SCK + MS * 128, O_SSK = O_SCV + MS * 128, O_SSV = O_SSK + MS * 128,
                 O_SWK = O_SSV + MS * 128, O_SWV = O_SWK + (size_t)MS * 512 * 128, O_SCH = O_SWV + (size_t)MS * 512 * 128, O_END = O_SCH + (size_t)MS * DB;
constexpr size_t MiB = 1u << 20;
constexpr size_t WS_CTL = 0, CTL_ZERO_BYTES = 1 * MiB;
constexpr size_t WS_W1IN = 2 * MiB, WS_W1OUT = 13 * MiB, WS_WIN = 19 * MiB, WS_WAB = 28 * MiB, WS_WOUT = 30 * MiB, WS_W2IN = 32 * MiB, WS_W2OUT = 43 * MiB, WS_CW1 = 49 * MiB  , WS_SMALL = 50 * MiB;
constexpr size_t ROWB2 = (size_t)MR * 2, ROWB4 = (size_t)MR * 4;
constexpr size_t WS_XB = 52 * MiB;
constexpr size_t WS_ACT = WS_XB + ROWB2 * DM + MiB;
constexpr size_t WS_PRE = WS_ACT + ROWB2 * FF + MiB;
constexpr size_t WS_SC = WS_ACT;
constexpr size_t WS_H = WS_PRE + ROWB4 * DM + MiB;
constexpr size_t WS_HB = WS_H + ROWB4 * DM + MiB;
constexpr size_t WS_QB = WS_HB + ROWB2 * DM + MiB;
constexpr size_t WS_KVB = WS_QB + ROWB2 * QW + MiB;
constexpr size_t KVB_T = (size_t)NB * 2 * TSEQ * 64;
constexpr size_t WS_AZ = WS_KVB + 6 * KVB_T * 2 + MiB;
constexpr size_t WS_UB = WS_AZ + ROWB2 * DM + MiB;
constexpr size_t WS_VB = WS_UB + ROWB2 * DB + MiB;
constexpr size_t WS_SGA = WS_VB + ROWB2 * DB + MiB;
constexpr size_t WS_SGB = WS_SGA + ROWB2 * DM + MiB;
constexpr size_t WS_GT = WS_SGB + ROWB2 * DM + MiB;
constexpr size_t WS_MB = WS_GT + ROWB4 * 24 + MiB;
constexpr size_t WS_KCP = WS_MB + ROWB2 * DM + MiB;
constexpr size_t WS_KCS = WS_KCP + 2 * 8 * 512 * 64 * 2 + MiB;
constexpr size_t WS_HCS = WS_KCS + (size_t)2 * 64 * 1024 * 64 * 2 + MiB;
constexpr size_t WS_HCP = WS_HCS + (size_t)2 * 65536 * 256 * 4 + MiB;
constexpr size_t WS_END = WS_HCP + (size_t)2 * 4096 * 256 * 4 + MiB;
static_assert(WS_SC + (size_t)2 * 65536 * 1024 * 2 <= WS_H, "sample cache overlay fits in ACT|PRE");
constexpr size_t SM_CBIAS = 0;
constexpr size_t SM_W2T = 4096;
constexpr size_t SM_KVS = 65536;
constexpr int CW_TMO = 0, CW_CODE = 1, CW_BAR = 4096;

constexpr int RING_OFF = 0, RING_BYTES = 131072;
constexpr int LDSCTL_OFF = RING_BYTES, MISC_OFF = LDSCTL_OFF + 320;
constexpr int LDS_BYTES = 147456;
static_assert(MISC_OFF + 128 <= LDS_BYTES, "LDS map");

#define GAS __attribute__((address_space(1)))
#define LAS __attribute__((address_space(3)))
typedef unsigned short bf16;
typedef unsigned v4u __attribute__((ext_vector_type(4)));
typedef unsigned v2u __attribute__((ext_vector_type(2)));
typedef float f32x4 __attribute__((ext_vector_type(4)));
typedef float f32x16 __attribute__((ext_vector_type(16)));
typedef short bf16x8 __attribute__((ext_vector_type(8)));
typedef GAS unsigned gu32;
#define RLX_AGENT __ATOMIC_RELAXED, __HIP_MEMORY_SCOPE_AGENT
#define LDS_WAIT() asm volatile("s_waitcnt lgkmcnt(0)" ::: "memory")
#define VM_WAIT() asm volatile("s_waitcnt vmcnt(0)" ::: "memory")
__device__ __forceinline__ unsigned f2bf(float f) { unsigned u = __builtin_bit_cast(unsigned, f); return (u + 0x7fffu + ((u >> 16) & 1u)) >> 16; }
__device__ __forceinline__ unsigned pk2(float lo, float hi) { return f2bf(lo) | (f2bf(hi) << 16); }
__device__ __forceinline__ float bf2f(unsigned v) { return __uint_as_float(v << 16); }
__device__ __forceinline__ float bflo(unsigned w) { return __uint_as_float(w << 16); }
__device__ __forceinline__ float bfhi(unsigned w) { return __uint_as_float(w & 0xffff0000u); }
__device__ __forceinline__ float sigmoidf_(float x) { return 1.0f / (1.0f + __expf(-x)); }
__device__ __forceinline__ float siluf_(float x) { return x / (1.0f + __expf(-x)); }
__device__ __forceinline__ float gelu_tanh_(float x) { const float u = 1.5957691216057308f * (x + 0.044715f * x * x * x); return x / (1.0f + __expf(-u)); }
__device__ __forceinline__ float wave_sum(float v) {
#pragma unroll
    for (int o = 1; o < 64; o <<= 1) v += __shfl_xor(v, o);
    return v;
}
__device__ __forceinline__ float wave_max(float v) {
#pragma unroll
    for (int o = 1; o < 64; o <<= 1) v = fmaxf(v, __shfl_xor(v, o));
    return v;
}

#define XB_TMO      128
#define XB_XCNT(j)  (256  + 64 * (j))
#define XB_XSUB(j)  (1280 + 64 * (j))
#define XB_XGEN(j)  (2304 + 64 * (j))
#define XB_TOP      3328
#define XB_TOPGEN   3392
#define XCD_BAR_WORDS 3456
#define XB_SPIN_CAP (1u << 18)

__device__ __forceinline__ unsigned xb_ld(unsigned* p)              { return __hip_atomic_load(p, __ATOMIC_RELAXED, __HIP_MEMORY_SCOPE_AGENT); }
__device__ __forceinline__ unsigned xb_add(unsigned* p, unsigned v) { return __hip_atomic_fetch_add(p, v, __ATOMIC_RELAXED, __HIP_MEMORY_SCOPE_AGENT); }
__device__ __forceinline__ unsigned xb_xcc_id() { return (unsigned)__builtin_amdgcn_s_getreg((3 << 11) | 20) & 0xFu; }
#define XB_SPIN(cond, bar) do { unsigned _sp = 0; while (cond) { __builtin_amdgcn_s_sleep(1); \
    if ((++_sp & 255u) == 0u) { if (xb_ld(&(bar)[XB_TMO])) break; if (_sp > XB_SPIN_CAP) { atomicAdd(&(bar)[XB_TMO], 1u); break; } } } } while (0)

struct XcdBarrier { unsigned* bar; unsigned x; volatile LAS unsigned* st; };

__device__ __forceinline__ XcdBarrier xcd_barrier_post(unsigned* bar, volatile LAS unsigned* st) {
    XcdBarrier b; b.bar = bar; b.x = xb_xcc_id(); b.st = st;
    if (threadIdx.x == 0) (void)xb_add(&bar[XB_XCNT(b.x)], 1u);
    return b;
}
__device__ __forceinline__ void xcd_barrier_complete(unsigned* bar, unsigned x, unsigned& nloc, unsigned& nx) {
    const unsigned G = gridDim.x * gridDim.y * gridDim.z;
    unsigned sum, cnt, mine, sp = 0u;
    for (;;) {
        sum = 0u; cnt = 0u; mine = 0u;
#pragma unroll
        for (unsigned j = 0; j < 16; ++j) { const unsigned c = xb_ld(&bar[XB_XCNT(j)]); sum += c; cnt += (c > 0u) ? 1u : 0u; mine = (j == x) ? c : mine; }
        if (sum == G) break;
        __builtin_amdgcn_s_sleep(1);
        if ((++sp & 255u) == 0u) { if (xb_ld(&bar[XB_TMO])) break; if (sp > XB_SPIN_CAP) { atomicAdd(&bar[XB_TMO], 1u); break; } }
    }
    nloc = mine > 0u ? mine : 1u; nx = cnt > 0u ? cnt : 1u;
}
__device__ __forceinline__ void xcd_barrier(const XcdBarrier& b) {
    asm volatile("s_waitcnt vmcnt(0)" ::: "memory");
    __syncthreads();
    if (threadIdx.x == 0) {
        unsigned* bar = b.bar;
        __builtin_amdgcn_s_waitcnt(0);
        unsigned nloc = b.st[0], nx = b.st[1];
        if (nloc == 0u) { xcd_barrier_complete(bar, b.x, nloc, nx); b.st[0] = nloc; b.st[1] = nx; }
        const unsigned old = xb_add(&bar[XB_XSUB(b.x)], 1u);
        const unsigned gen = old / nloc;
        if (old + 1u == (gen + 1u) * nloc) {
            __builtin_amdgcn_fence(__ATOMIC_RELEASE, "agent");
            asm volatile("s_waitcnt vmcnt(0)" ::: "memory");
            const unsigned og = xb_add(&bar[XB_TOP], 1u);
            const unsigned tg = og / nx;
            if (og + 1u == (tg + 1u) * nx) xb_add(&bar[XB_TOPGEN], 1u);
            else XB_SPIN(xb_ld(&bar[XB_TOPGEN]) == tg, bar);
            __builtin_amdgcn_fence(__ATOMIC_ACQUIRE, "agent");
            xb_add(&bar[XB_XGEN(b.x)], 1u);
            asm volatile("s_waitcnt vmcnt(0)" ::: "memory");
        } else {
            XB_SPIN(xb_ld(&bar[XB_XGEN(b.x)]) == gen, bar);
            __builtin_amdgcn_fence(__ATOMIC_ACQUIRE, "agent");
            asm volatile("s_waitcnt vmcnt(0)" ::: "memory");
        }
    }
    __syncthreads();
}

struct Frame {
    LAS unsigned char* lds;
    volatile LAS unsigned* MISC;
    gu32* ctl;
    int tid, lane, wave;
    int vcu, G;
    float* out; unsigned char* ws;
    __device__ __forceinline__ unsigned char* wsb_() const { unsigned char* p = ws; asm volatile("" : "+s"(p)); return p; }
    __device__ __forceinline__ const void* inp_(int k) const { const void* const* ka = (const void* const*)__builtin_amdgcn_kernarg_segment_ptr(); asm volatile("" : "+s"(ka)); return ka[k]; }
    __device__ __forceinline__ const float* x() const { return (const float*)inp_(0); }
    __device__ __forceinline__ const float* xs() const { return (const float*)inp_(1); }
    __device__ __forceinline__ const float* cck() const { return (const float*)inp_(2); }
    __device__ __forceinline__ const float* ccv() const { return (const float*)inp_(3); }
    __device__ __forceinline__ const float* csk() const { return (const float*)inp_(4); }
    __device__ __forceinline__ const float* csv() const { return (const float*)inp_(5); }
    __device__ __forceinline__ const float* cwk() const { return (const float*)inp_(6); }
    __device__ __forceinline__ const float* cwv() const { return (const float*)inp_(7); }
    __device__ __forceinline__ const int* pt() const { return (const int*)inp_(8); }
    __device__ __forceinline__ const float* f1wi() const { return (const float*)inp_(9); }
    __device__ __forceinline__ const float* f1wo() const { return (const float*)inp_(10); }
    __device__ __forceinline__ const float* ln1g() const { return (const float*)inp_(11); }
    __device__ __forceinline__ const float* ln1b() const { return (const float*)inp_(12); }
    __device__ __forceinline__ const float* win() const { return (const float*)inp_(13); }
    __device__ __forceinline__ const float* pek() const { return (const float*)inp_(14); }
    __device__ __forceinline__ const float* w1k() const { return (const float*)inp_(15); }
    __device__ __forceinline__ const float* w2k() const { return (const float*)inp_(16); }
    __device__ __forceinline__ const float* pev() const { return (const float*)inp_(17); }
    __device__ __forceinline__ const float* w1v() const { return (const float*)inp_(18); }
    __device__ __forceinline__ const float* w2v() const { return (const float*)inp_(19); }
    __device__ __forceinline__ const float* glg() const { return (const float*)inp_(20); }
    __device__ __forceinline__ const float* glb() const { return (const float*)inp_(21); }
    __device__ __forceinline__ const float* spw() const { return (const float*)inp_(22); }
    __device__ __forceinline__ const float* spb() const { return (const float*)inp_(23); }
    __device__ __forceinline__ const float* wa() const { return (const float*)inp_(24); }
    __device__ __forceinline__ const float* wb() const { return (const float*)inp_(25); }
    __device__ __forceinline__ const float* wout() const { return (const float*)inp_(26); }
    __device__ __forceinline__ const float* ln2g() const { return (const float*)inp_(27); }
    __device__ __forceinline__ const float* ln2b() const { return (const float*)inp_(28); }
    __device__ __forceinline__ const float* f2wi() const { return (const float*)inp_(29); }
    __device__ __forceinline__ const float* f2wo() const { return (const float*)inp_(30); }
    __device__ __forceinline__ const float* ln3g() const { return (const float*)inp_(31); }
    __device__ __forceinline__ const float* ln3b() const { return (const float*)inp_(32); }
    __device__ __forceinline__ bf16* W1IN() const { return (bf16*)(wsb_() + (WS_W1IN)); }
    __device__ __forceinline__ bf16* W1OUT() const { return (bf16*)(wsb_() + (WS_W1OUT)); }
    __device__ __forceinline__ bf16* WIN() const { return (bf16*)(wsb_() + (WS_WIN)); }
    __device__ __forceinline__ bf16* WAB() const { return (bf16*)(wsb_() + (WS_WAB)); }
    __device__ __forceinline__ bf16* WOUT() const { return (bf16*)(wsb_() + (WS_WOUT)); }
    __device__ __forceinline__ bf16* W2IN() const { return (bf16*)(wsb_() + (WS_W2IN)); }
    __device__ __forceinline__ bf16* W2OUT() const { return (bf16*)(wsb_() + (WS_W2OUT)); }
    __device__ __forceinline__ bf16* CW1() const { return (bf16*)(wsb_() + (WS_CW1)); }
    __device__ __forceinline__ bf16* XB() const { return (bf16*)(wsb_() + (WS_XB)); }
    __device__ __forceinline__ bf16* ACT() const { return (bf16*)(wsb_() + (WS_ACT)); }
    __device__ __forceinline__ bf16* HB() const { return (bf16*)(wsb_() + (WS_HB)); }
    __device__ __forceinline__ bf16* QB() const { return (bf16*)(wsb_() + (WS_QB)); }
    __device__ __forceinline__ bf16* KVB() const { return (bf16*)(wsb_() + (WS_KVB)); }
    __device__ __forceinline__ bf16* AZ() const { return (bf16*)(wsb_() + (WS_AZ)); }
    __device__ __forceinline__ bf16* UB() const { return (bf16*)(wsb_() + (WS_UB)); }
    __device__ __forceinline__ bf16* VB() const { return (bf16*)(wsb_() + (WS_VB)); }
    __device__ __forceinline__ bf16* SGA() const { return (bf16*)(wsb_() + (WS_SGA)); }
    __device__ __forceinline__ bf16* SGB() const { return (bf16*)(wsb_() + (WS_SGB)); }
    __device__ __forceinline__ bf16* MB() const { return (bf16*)(wsb_() + (WS_MB)); }
    __device__ __forceinline__ bf16* KCP() const { return (bf16*)(wsb_() + (WS_KCP)); }
    __device__ __forceinline__ bf16* KCS() const { return (bf16*)(wsb_() + (WS_KCS)); }
    __device__ __forceinline__ bf16* SC() const { return (bf16*)(wsb_() + (WS_SC)); }
    __device__ __forceinline__ bf16* W2T() const { return (bf16*)(wsb_() + (WS_SMALL + SM_W2T)); }
    __device__ __forceinline__ float* PRE() const { return (float*)(wsb_() + (WS_PRE)); }
    __device__ __forceinline__ float* H() const { return (float*)(wsb_() + (WS_H)); }
    __device__ __forceinline__ float* GT() const { return (float*)(wsb_() + (WS_GT)); }
    __device__ __forceinline__ float* HCS() const { return (float*)(wsb_() + (WS_HCS)); }
    __device__ __forceinline__ float* HCP() const { return (float*)(wsb_() + (WS_HCP)); }
    __device__ __forceinline__ float* CBIAS() const { return (float*)(wsb_() + (WS_SMALL + SM_CBIAS)); }
    __device__ __forceinline__ float* KVS() const { return (float*)(wsb_() + (WS_SMALL + SM_KVS)); }
};
using pg8::Unit;
struct EpiF32 {
    static constexpr bool PERM = false, MIDK = false;
    float* C; int ldc;
    __device__ __forceinline__ void operator()(const f32x4 (&acc)[2][2][4][2], const Unit& u, int wr, int wc, int fr, int fq) const {
        const int row0 = u.pm * 256 + wr * 64 + fr, col0 = u.pn * 256 + wc * 32 + 4 * fq;
#pragma unroll
        for (int ai = 0; ai < 2; ++ai)
#pragma unroll
            for (int m = 0; m < 4; ++m) { float* rowp = C + (size_t)(row0 + ai * 128 + m * 16) * ldc + col0;
#pragma unroll
                for (int bj = 0; bj < 2; ++bj)
#pragma unroll
                    for (int n = 0; n < 2; ++n) *(f32x4*)(rowp + bj * 128 + n * 16) = acc[ai][bj][m][n]; }
    }
};
struct EpiResid {
    static constexpr bool PERM = false, MIDK = false;
    const float* res; float* out; float a, b;
    __device__ __forceinline__ void operator()(const f32x4 (&acc)[2][2][4][2], const Unit& u, int wr, int wc, int fr, int fq) const {
        const int row0 = u.pm * 256 + wr * 64 + fr, col0 = u.pn * 256 + wc * 32 + 4 * fq;
#pragma unroll
        for (int ai = 0; ai < 2; ++ai)
#pragma unroll
            for (int m = 0; m < 4; ++m) { const size_t off = (size_t)(row0 + ai * 128 + m * 16) * DM + col0;
#pragma unroll
                for (int bj = 0; bj < 2; ++bj)
#pragma unroll
                    for (int n = 0; n < 2; ++n) { const f32x4 r = *(const f32x4*)(res + off + bj * 128 + n * 16); *(f32x4*)(out + off + bj * 128 + n * 16) = r * a + acc[ai][bj][m][n] * b; } }
    }
};
struct EpiSwiglu {
    static constexpr bool PERM = true, MIDK = false;
    bf16* O;
    __device__ __forceinline__ void operator()(const f32x4 (&acc)[2][2][4][2], const Unit& u, int wr, int wc, int fr, int fq) const {
        const int row0 = u.pm * 256 + wr * 64 + fr, col0 = u.pn * 128 + wc * 32 + 8 * fq;
#pragma unroll
        for (int ai = 0; ai < 2; ++ai)
#pragma unroll
            for (int m = 0; m < 4; ++m) { bf16* rowp = O + (size_t)(row0 + ai * 128 + m * 16) * FF + col0;
                const f32x4 g0 = acc[ai][0][m][0], g1 = acc[ai][0][m][1], u0 = acc[ai][1][m][0], u1 = acc[ai][1][m][1];
                v4u w; w.x = pg8::cvt_pk_bf16(siluf_(g0[0]) * u0[0], siluf_(g0[1]) * u0[1]); w.y = pg8::cvt_pk_bf16(siluf_(g0[2]) * u0[2], siluf_(g0[3]) * u0[3]);
                w.z = pg8::cvt_pk_bf16(siluf_(g1[0]) * u1[0], siluf_(g1[1]) * u1[1]); w.w = pg8::cvt_pk_bf16(siluf_(g1[2]) * u1[2], siluf_(g1[3]) * u1[3]);
                *(v4u*)rowp = w; }
    }
};
__device__ __forceinline__ v4u pack8(const f32x4 a, const f32x4 b) { v4u w; w.x = pg8::cvt_pk_bf16(a[0], a[1]); w.y = pg8::cvt_pk_bf16(a[2], a[3]); w.z = pg8::cvt_pk_bf16(b[0], b[1]); w.w = pg8::cvt_pk_bf16(b[2], b[3]); return w; }
struct EpiProj {
    static constexpr bool PERM = true, MIDK = false;
    bf16 *QB, *KVB, *UB, *VB, *SGA, *SGB; float* GT; float* out;
    __device__ __forceinline__ void operator()(const f32x4 (&acc)[2][2][4][2], const Unit& u, int wr, int wc, int fr, int fq) const {
        const int pn = u.pn; const int row0 = u.pm * 256 + wr * 64 + fr;
#pragma unroll
        for (int ai = 0; ai < 2; ++ai)
#pragma unroll
            for (int m = 0; m < 4; ++m) { const int row = row0 + ai * 128 + m * 16;
#pragma unroll
                for (int bj = 0; bj < 2; ++bj) { f32x4 v0 = acc[ai][bj][m][0], v1 = acc[ai][bj][m][1]; const int cl0 = bj * 128 + wc * 32 + 8 * fq;
                    if (pn < 2) { *(v4u*)(QB + (size_t)row * QW + pn * 256 + cl0) = pack8(v0 * 0.125f, v1 * 0.125f); }
                    else if (pn < 5) { const int ti = (pn - 2) * 2 + bj, c0 = wc * 32 + 8 * fq, b = row >> 13, t = row & 8191, gg = c0 >> 6, d0 = c0 & 63;
                        *(v4u*)(KVB + (size_t)ti * KVB_T + ((size_t)((b * 2 + gg) * TSEQ + t)) * 64 + d0) = pack8(v0, v1);
                        if (ti < 4) { float* o = out + O_PCK + (size_t)ti * MP * 128 + (size_t)row * 128 + c0; *(f32x4*)o = v0; *(f32x4*)(o + 4) = v1; }
                        else if (t >= TSEQ - 512) { float* o = out + (ti == 4 ? O_PWK : O_PWV) + ((size_t)(b * 512 + t - (TSEQ - 512))) * 128 + c0; *(f32x4*)o = v0; *(f32x4*)(o + 4) = v1; } }
                    else if (pn < 9) { f32x4 a, c;
#pragma unroll
                        for (int i = 0; i < 4; ++i) { a[i] = gelu_tanh_(v0[i]); c[i] = gelu_tanh_(v1[i]); }
                        bf16* dst = (pn < 7) ? (UB + (size_t)row * DB + (pn - 5) * 256 + cl0) : (VB + (size_t)row * DB + (pn - 7) * 256 + cl0); *(v4u*)dst = pack8(a, c); }
                    else if (pn < 17) { if (bj == 0) { const f32x4 w0 = acc[ai][1][m][0], w1 = acc[ai][1][m][1]; f32x4 ra, rc, gb0, gb1;
#pragma unroll
                            for (int i = 0; i < 4; ++i) { gb0[i] = sigmoidf_(w0[i]); gb1[i] = sigmoidf_(w1[i]); ra[i] = sigmoidf_(v0[i]) / gb0[i]; rc[i] = sigmoidf_(v1[i]) / gb1[i]; }
                            const size_t o = (size_t)row * DM + (pn - 9) * 128 + wc * 32 + 8 * fq; *(v4u*)(SGA + o) = pack8(ra, rc); *(v4u*)(SGB + o) = pack8(gb0, gb1); } }
                    else { if (bj == 0 && wc == 0 && fq < 3) { f32x4 a, c;
#pragma unroll
                            for (int i = 0; i < 4; ++i) { a[i] = sigmoidf_(v0[i]); c[i] = sigmoidf_(v1[i]); }
                            float* o = GT + (size_t)row * 24 + 8 * fq; *(f32x4*)o = a; *(f32x4*)(o + 4) = c; } }
                } }
    }
};
struct EpiMerge {
    static constexpr bool PERM = true, MIDK = true;
    const bf16 *SGA, *SGB; bf16* MB;
    __device__ __forceinline__ void mid(f32x4 (&acc)[2][2][4][2], const Unit& u, int wr, int wc, int fr, int fq) const {
        unsigned off0 = (unsigned)(u.pm * 256 + wr * 64 + fr) * DM + u.pn * 256 + wc * 32 + 8 * fq;
        asm volatile("" : "+v"(off0));
#pragma unroll
        for (int ai = 0; ai < 2; ++ai)
#pragma unroll
            for (int m = 0; m < 4; ++m) {
#pragma unroll
                for (int bj = 0; bj < 2; ++bj) { const v4u ga = *(const v4u*)(SGA + off0 + (unsigned)((ai * 128 + m * 16) * DM + bj * 128));
                    f32x4 r0, r1; r0[0] = bflo(ga.x); r0[1] = bfhi(ga.x); r0[2] = bflo(ga.y); r0[3] = bfhi(ga.y); r1[0] = bflo(ga.z); r1[1] = bfhi(ga.z); r1[2] = bflo(ga.w); r1[3] = bfhi(ga.w);
                    acc[ai][bj][m][0] *= r0; acc[ai][bj][m][1] *= r1;
                    asm volatile("" : "+v"(acc[ai][bj][m][0]), "+v"(acc[ai][bj][m][1]) :: "memory"); } }
    }
    __device__ __forceinline__ void operator()(const f32x4 (&acc)[2][2][4][2], const Unit& u, int wr, int wc, int fr, int fq) const {
        const unsigned off0 = (unsigned)(u.pm * 256 + wr * 64 + fr) * DM + u.pn * 256 + wc * 32 + 8 * fq;
#pragma unroll
        for (int ai = 0; ai < 2; ++ai)
#pragma unroll
            for (int m = 0; m < 4; ++m) {
#pragma unroll
                for (int bj = 0; bj < 2; ++bj) { const unsigned off = off0 + (unsigned)((ai * 128 + m * 16) * DM + bj * 128);
                    const v4u gb = *(const v4u*)(SGB + off);
                    f32x4 r0, r1; r0[0] = bflo(gb.x); r0[1] = bfhi(gb.x); r0[2] = bflo(gb.y); r0[3] = bfhi(gb.y); r1[0] = bflo(gb.z); r1[1] = bfhi(gb.z); r1[2] = bflo(gb.w); r1[3] = bfhi(gb.w);
                    *(v4u*)(MB + off) = pack8(acc[ai][bj][m][0] * r0, acc[ai][bj][m][1] * r1); }
                asm volatile("" ::: "memory"); }
    }
};

__device__ __forceinline__ int crow(int r, int hi) { return (r & 3) + 8 * (r >> 2) + 4 * hi; }
#define MFMA32(a, b, c) __builtin_amdgcn_mfma_f32_32x32x16_bf16((a), (b), (c), 0, 0, 0)
#define MFMA16(a, b, c) __builtin_amdgcn_mfma_f32_16x16x32_bf16((a), (b), (c), 0, 0, 0)
__device__ __forceinline__ f32x16 sk_partial(const bf16* A, int lda, const bf16* Bt, int ldb, int k0, int nk, int lane) {
    const int r32 = lane & 31, hi = lane >> 5; f32x16 acc = {};
    const bf16* ap = A + (size_t)r32 * lda + k0 + 8 * hi; const bf16* bp = Bt + (size_t)r32 * ldb + k0 + 8 * hi;
#pragma unroll 4
    for (int s = 0; s < nk; ++s) { const bf16x8 a = *(const bf16x8*)(ap + 16 * s), b = *(const bf16x8*)(bp + 16 * s); acc = MFMA32(a, b, acc); }
    return acc;
}
__device__ __forceinline__ void sk_store(LAS float* red, const f32x16& acc, int lane) {
    const int r32 = lane & 31, hi = lane >> 5;
#pragma unroll
    for (int x = 0; x < 16; ++x) red[crow(x, hi) * 32 + r32] = acc[x];
}
__device__ __forceinline__ float sk_sum(const LAS float* red, int e, int w0, int w1) { float s = 0.f; for (int w = w0; w < w1; ++w) s += red[w * 1024 + e]; return s; }

__device__ __forceinline__ void sk_ffn_in(Frame& F, const bf16* A, const bf16* Wt) {
    LAS float* red = (LAS float*)(F.lds + RING_OFF);
    for (int item = blockIdx.x; item < FF / 32; item += F.G) {
        const int c0 = 32 * item, j = c0 >> 7, w = c0 & 127;
        const f32x16 ag = sk_partial(A, DM, Wt + (size_t)(256 * j + w) * DM, DM, F.wave * 128, 8, F.lane);
        const f32x16 au = sk_partial(A, DM, Wt + (size_t)(256 * j + 128 + w) * DM, DM, F.wave * 128, 8, F.lane);
        sk_store(red + F.wave * 1024, ag, F.lane); sk_store(red + 8192 + F.wave * 1024, au, F.lane);
        __syncthreads();
        for (int e = F.tid; e < 1024; e += 512) { const float gv = sk_sum(red, e, 0, 8), uv = sk_sum(red + 8192, e, 0, 8);
            F.ACT()[(size_t)(MP + (e >> 5)) * FF + c0 + (e & 31)] = (bf16)f2bf(siluf_(gv) * uv); }
        __syncthreads();
    }
}
__device__ __forceinline__ void sk_resid(Frame& F, const bf16* A, int lda, const bf16* Wt, int ldb, int nk, const float* res, float a, float b) {
    LAS float* red = (LAS float*)(F.lds + RING_OFF);
    for (int item = blockIdx.x; item < DM / 32; item += F.G) {
        const int n0 = 32 * item;
        const f32x16 acc = sk_partial(A, lda, Wt + (size_t)n0 * ldb, ldb, F.wave * 16 * nk, nk, F.lane);
        sk_store(red + F.wave * 1024, acc, F.lane);
        __syncthreads();
        for (int e = F.tid; e < 1024; e += 512) { const int r = e >> 5, n = n0 + (e & 31); F.PRE()[(size_t)(MP + r) * DM + n] = a * res[(size_t)r * DM + n] + b * sk_sum(red, e, 0, 8); }
        __syncthreads();
    }
}
__device__ __forceinline__ void proj_elem(Frame& F, int srow, int n, float v) {
    const int pn = n >> 8, cl = n & 255; const size_t R = (size_t)MP + srow;
    if (pn < 2) F.QB()[R * QW + n] = (bf16)f2bf(v * 0.125f);
    else if (pn < 5) { const int ti = (pn - 2) * 2 + (cl >> 7), c = cl & 127;
        F.KVS()[(ti * 32 + srow) * 128 + c] = v;
        if (ti < 4) F.out[O_SCK + (size_t)ti * MS * 128 + srow * 128 + c] = v;
        else F.out[(ti == 4 ? O_SWK : O_SWV) + ((size_t)srow * 512 + 511) * 128 + c] = v; }
    else if (pn < 7) F.UB()[R * DB + (n - 1280)] = (bf16)f2bf(gelu_tanh_(v));
    else if (pn < 9) F.VB()[R * DB + (n - 1792)] = (bf16)f2bf(gelu_tanh_(v));
    else if (pn < 17) { const int c = (pn - 9) * 128 + (cl & 127); if (cl < 128) F.SGA()[R * DM + c] = (bf16)f2bf(sigmoidf_(v)); else F.SGB()[R * DM + c] = (bf16)f2bf(sigmoidf_(v)); }
    else if (n < 4352 + 24) F.GT()[R * 24 + (n - 4352)] = sigmoidf_(v);
}
__device__ __forceinline__ void sk_proj(Frame& F) {
    LAS float* red = (LAS float*)(F.lds + RING_OFF);
    const bf16* A = F.HB() + (size_t)MP * DM;
    for (int item = blockIdx.x; item < NPROJ / 32; item += F.G) {
        const int n0 = 32 * item;
        const f32x16 acc = sk_partial(A, DM, F.WIN() + (size_t)n0 * DM, DM, F.wave * 128, 8, F.lane);
        sk_store(red + F.wave * 1024, acc, F.lane);
        __syncthreads();
        for (int e = F.tid; e < 1024; e += 512) proj_elem(F, e >> 5, n0 + (e & 31), sk_sum(red, e, 0, 8));
        __syncthreads();
    }
}
__device__ __forceinline__ void sk_merge(Frame& F) {
    LAS float* red = (LAS float*)(F.lds + RING_OFF);
    const bf16* A = F.AZ() + (size_t)MP * DM;
    for (int item = blockIdx.x; item < DM / 32; item += F.G) {
        const int n0 = 32 * item;
        const f32x16 acc = sk_partial(A, DM, F.WAB() + (size_t)n0 * DM, DM, F.wave * 128, 8, F.lane);
        sk_store(red + F.wave * 1024, acc, F.lane);
        __syncthreads();
        for (int e = F.tid; e < 1024; e += 512) { const size_t off = (size_t)(MP + (e >> 5)) * DM + n0 + (e & 31);
            F.MB()[off] = (bf16)f2bf(bf2f(F.SGA()[off]) * sk_sum(red, e, 0, 4) + bf2f(F.SGB()[off]) * sk_sum(red, e, 4, 8)); }
        __syncthreads();
    }
}
__device__ __forceinline__ void tr_item(const float* W, int ldw, int srow0, int scol0, int nvalid, bf16* WT, int ldk, int drow0, int dk0, LAS float* scr, int lane) {
    const int n = lane & 31;
#pragma unroll 8
    for (int i = 0; i < 32; ++i) { const int kk = 2 * i + (lane >> 5); scr[kk * 33 + n] = (n < nvalid) ? W[(size_t)(srow0 + kk) * ldw + scol0 + n] : 0.f; }
    LDS_WAIT(); asm volatile("" ::: "memory");
    const int c = lane & 7;
#pragma unroll
    for (int j = 0; j < 4; ++j) { const int nn = (lane >> 3) + 8 * j; const LAS float* s = scr + (8 * c) * 33 + nn;
        v4u o; o.x = pk2(s[0 * 33], s[1 * 33]); o.y = pk2(s[2 * 33], s[3 * 33]); o.z = pk2(s[4 * 33], s[5 * 33]); o.w = pk2(s[6 * 33], s[7 * 33]);
        *(GAS v4u*)(WT + (size_t)(drow0 + nn) * ldk + dk0 + 8 * c) = o; }
    LDS_WAIT(); asm volatile("" ::: "memory");
}
__device__ __forceinline__ void p0_prologue(Frame& F) {
    LAS float* scr = (LAS float*)(F.lds + RING_OFF + F.wave * 16384);
    const int gw = F.vcu * NWAVES + F.wave, NGW = F.G * NWAVES, lane = F.lane;
    constexpr int I_FI = 16 * 176, I_FO = 44 * 32, I_WIN = 16 * 144, I_AB = 8 * 32, I_WO = 16 * 32, I_C1 = 16 * 4, I_W2 = 2 * 2;
    constexpr int NITEMS = 2 * I_FI + 2 * I_FO + I_WIN + 2 * I_AB + I_WO + 4 * I_C1 + 2 * I_W2;
    for (int it = gw; it < NITEMS; it += NGW) {
        int r = it;
        if (r < 2 * I_FI) { const float* W = r < I_FI ? F.f1wi() : F.f2wi(); bf16* WT = r < I_FI ? F.W1IN() : F.W2IN(); if (r >= I_FI) r -= I_FI;
            const int kb = r / 176, nb = r % 176, j = nb >> 3, w = nb & 7; const int sc = (w < 4) ? (128 * j + 32 * w) : (FF + 128 * j + 32 * (w - 4));
            tr_item(W, NFF2, 64 * kb, sc, 32, WT, DM, 32 * nb, 64 * kb, scr, lane); continue; }
        r -= 2 * I_FI;
        if (r < 2 * I_FO) { const float* W = r < I_FO ? F.f1wo() : F.f2wo(); bf16* WT = r < I_FO ? F.W1OUT() : F.W2OUT(); if (r >= I_FO) r -= I_FO;
            const int kb = r / 32, nb = r % 32; tr_item(W, DM, 64 * kb, 32 * nb, 32, WT, FF, 32 * nb, 64 * kb, scr, lane); continue; }
        r -= 2 * I_FO;
        if (r < I_WIN) { const int kb = r / 144, nb = r % 144, d0 = 32 * nb; int sc, nv = 32;
            if (d0 < 1280) sc = d0; else if (d0 < 1792) sc = 1304 + (d0 - 1280); else if (d0 < 2304) sc = 1816 + (d0 - 1792); else if (d0 < 4352) { const int jj = (d0 - 2304) >> 8, ww = (d0 - 2304) & 255; sc = (ww < 128) ? (2328 + 128 * jj + ww) : (3352 + 128 * jj + (ww - 128)); }
            else if (d0 == 4352) { sc = 1280; nv = 24; } else { sc = 0; nv = 0; }
            tr_item(F.win(), 4376, 64 * kb, sc, nv, F.WIN(), DM, d0, 64 * kb, scr, lane); continue; }
        r -= I_WIN;
        if (r < 2 * I_AB) { const float* W = r < I_AB ? F.wa() : F.wb(); const int dk = r < I_AB ? 0 : 512; if (r >= I_AB) r -= I_AB;
            const int kb = r / 32, nb = r % 32; tr_item(W, DM, 64 * kb, 32 * nb, 32, F.WAB(), DM, 32 * nb, dk + 64 * kb, scr, lane); continue; }
        r -= 2 * I_AB;
        if (r < I_WO) { const int kb = r / 32, nb = r % 32; tr_item(F.wout(), DM, 64 * kb, 32 * nb, 32, F.WOUT(), DM, 32 * nb, 64 * kb, scr, lane); continue; }
        r -= I_WO;
        if (r < 4 * I_C1) { const int q = r / I_C1, kv = q >> 1, part = q & 1; r -= q * I_C1; const int kb = r / 4, nb = r % 4;
            tr_item(kv ? F.w1v() : F.w1k(), 128, 1024 * part + 64 * kb, 32 * nb, 32, F.CW1() + (size_t)kv * 256 * DM, DM, 128 * part + 32 * nb, 64 * kb, scr, lane); continue; }
        r -= 4 * I_C1;
        { const int kv = r / I_W2; r -= kv * I_W2; const int kb = r / 2, nb = r % 2; tr_item(kv ? F.w2v() : F.w2k(), 64, 64 * kb, 32 * nb, 32, F.W2T() + kv * 64 * 128, 128, 32 * nb, 64 * kb, scr, lane); }
    }
    for (int m = gw; m < MP + MS; m += NGW) {
        const float* xr = (m < MP) ? F.x() + (size_t)m * DM : F.xs() + (size_t)(m - MP) * DM; bf16* o = F.XB() + (size_t)m * DM;
#pragma unroll
        for (int j = 0; j < 4; ++j) { const f32x4 v = *(const f32x4*)(xr + 4 * lane + 256 * j); v2u w; w.x = pk2(v[0], v[1]); w.y = pk2(v[2], v[3]); *(v2u*)(o + 4 * lane + 256 * j) = w; }
    }
    for (int rr = gw; rr < 2 * 65536; rr += NGW) {
        const int kv = rr >> 16, r = rr & 65535, bg = r >> 10, ns = r & 1023, b = bg >> 1, g = bg & 1;
        const int page = F.pt()[b * NPAGE + (ns >> 3)];
        const float* src = (kv ? F.ccv() : F.cck()) + ((size_t)page * 128 + (ns & 7) * 16) * 128 + g * 64;
        bf16* o = F.SC() + (size_t)rr * 1024;
#pragma unroll
        for (int j = 0; j < 4; ++j) { const int e = 4 * lane + 256 * j, s = e >> 6, d = e & 63; const f32x4 v = *(const f32x4*)(src + s * 128 + d); v2u w; w.x = pk2(v[0], v[1]); w.y = pk2(v[2], v[3]); *(v2u*)(o + e) = w; }
    }
    if (gw < 4) { const int kv = gw >> 1, n = (gw & 1) * 64 + lane; const float* pe = kv ? F.pev() : F.pek(); const float* w1 = kv ? F.w1v() : F.w1k(); float a = 0.f;
        for (int k = 0; k < 2048; ++k) a += pe[k] * w1[(size_t)k * 128 + n];
        F.CBIAS()[kv * 128 + n] = a; }
    for (int e = gw * 64 + lane; e < 2 * MS * 511 * 32; e += NGW * 64) {
        const int kv = e / (MS * 511 * 32), r = e % (MS * 511 * 32), b = r / (511 * 32), q = r % (511 * 32), w = q >> 5, c4 = q & 31;
        const f32x4 v = *(const f32x4*)((kv ? F.cwv() : F.cwk()) + ((size_t)(b * 512 + w + 1)) * 128 + 4 * c4);
        *(f32x4*)(F.out + (kv ? O_SWV : O_SWK) + ((size_t)(b * 512 + w)) * 128 + 4 * c4) = v;
    }
}
__device__ __forceinline__ void ln_phase(Frame& F, const float* src, const float* gam, const float* bet, float* of32_p, float* of32_s, bf16* ob16) {
    const int gw = F.vcu * NWAVES + F.wave, NGW = F.G * NWAVES, lane = F.lane;
    f32x4 gv[4], bv[4];
#pragma unroll
    for (int j = 0; j < 4; ++j) { gv[j] = *(const f32x4*)(gam + 4 * lane + 256 * j); bv[j] = *(const f32x4*)(bet + 4 * lane + 256 * j); }
    for (int m = gw; m < MP + MS; m += NGW) {
        const float* xr = src + (size_t)m * DM; f32x4 v[4]; float s = 0.f;
#pragma unroll
        for (int j = 0; j < 4; ++j) { v[j] = *(const f32x4*)(xr + 4 * lane + 256 * j); s += (v[j][0] + v[j][1]) + (v[j][2] + v[j][3]); }
        const float mean = wave_sum(s) * (1.f / DM); float s2 = 0.f;
#pragma unroll
        for (int j = 0; j < 4; ++j) { v[j] = v[j] - mean; s2 += (v[j][0] * v[j][0] + v[j][1] * v[j][1]) + (v[j][2] * v[j][2] + v[j][3] * v[j][3]); }
        const float rstd = 1.f / sqrtf(wave_sum(s2) * (1.f / DM) + LN_EPS);
        float* of = (m < MP) ? (of32_p ? of32_p + (size_t)m * DM : nullptr) : (of32_s ? of32_s + (size_t)(m - MP) * DM : nullptr);
#pragma unroll
        for (int j = 0; j < 4; ++j) { const f32x4 y = v[j] * rstd * gv[j] + bv[j];
            if (of) *(f32x4*)(of + 4 * lane + 256 * j) = y;
            if (ob16) { v2u w; w.x = pk2(y[0], y[1]); w.y = pk2(y[2], y[3]); *(v2u*)(ob16 + (size_t)m * DM + 4 * lane + 256 * j) = w; } }
    }
}
__device__ __forceinline__ void gmlp_chunk(Frame& F, int chunk) {
    LAS float* stats = (LAS float*)(F.lds + RING_OFF);
    LAS bf16* vnT = (LAS bf16*)(F.lds + RING_OFF + 1024);
    const int lane = F.lane, w = F.wave, row0 = chunk * 128;
    for (int tt = 0; tt < 16; ++tt) { const int t = 16 * w + tt; const v4u raw = *(const v4u*)(F.VB() + (size_t)(row0 + t) * DB + 8 * lane);
        float x[8] = {bflo(raw.x), bfhi(raw.x), bflo(raw.y), bfhi(raw.y), bflo(raw.z), bfhi(raw.z), bflo(raw.w), bfhi(raw.w)}; float s = 0.f;
#pragma unroll
        for (int i = 0; i < 8; ++i) s += x[i];
        const float mean = wave_sum(s) * (1.f / DB); float s2 = 0.f;
#pragma unroll
        for (int i = 0; i < 8; ++i) { const float d = x[i] - mean; s2 += d * d; }
        const float rstd = 1.f / sqrtf(wave_sum(s2) * (1.f / DB) + LN_EPS);
        if (lane == 0) { stats[2 * t] = mean; stats[2 * t + 1] = rstd; } }
    __syncthreads();
    for (int h = 0; h < 4; ++h) {
        for (int q = 0; q < 4; ++q) { const int idx = F.tid + 512 * q, t = idx >> 4, c8 = idx & 15; const v4u raw = *(const v4u*)(F.VB() + (size_t)(row0 + t) * DB + 128 * h + 8 * c8);
            const float mean = stats[2 * t], rstd = stats[2 * t + 1]; const float* gp = F.glg() + 128 * h + 8 * c8; const float* bp = F.glb() + 128 * h + 8 * c8;
            float x[8] = {bflo(raw.x), bfhi(raw.x), bflo(raw.y), bfhi(raw.y), bflo(raw.z), bfhi(raw.z), bflo(raw.w), bfhi(raw.w)};
#pragma unroll
            for (int i = 0; i < 8; ++i) vnT[(8 * c8 + i) * 136 + t] = (bf16)f2bf((x[i] - mean) * rstd * gp[i] + bp[i]); }
        __syncthreads();
        const int fr = lane & 15, quad = lane >> 4, s = 16 * w + fr, nks = (w >> 1) + 1;
        f32x4 acc[8];
#pragma unroll
        for (int ct = 0; ct < 8; ++ct) acc[ct] = (f32x4){0.f, 0.f, 0.f, 0.f};
        for (int ks = 0; ks < nks; ++ks) { const int t0 = 32 * ks + 8 * quad; const float* wp = F.spw() + ((size_t)(h * 128 + s)) * 128 + t0;
            const f32x4 w0 = *(const f32x4*)wp, w1 = *(const f32x4*)(wp + 4); float wv[8] = {w0[0], w0[1], w0[2], w0[3], w1[0], w1[1], w1[2], w1[3]};
#pragma unroll
            for (int i = 0; i < 8; ++i) if (t0 + i > s) wv[i] = 0.f;
            v4u aw; aw.x = pk2(wv[0], wv[1]); aw.y = pk2(wv[2], wv[3]); aw.z = pk2(wv[4], wv[5]); aw.w = pk2(wv[6], wv[7]); const bf16x8 a = __builtin_bit_cast(bf16x8, aw);
#pragma unroll
            for (int ct = 0; ct < 8; ++ct) { const bf16x8 b = *(const LAS bf16x8*)(vnT + (16 * ct + fr) * 136 + t0); acc[ct] = MFMA16(a, b, acc[ct]); } }
#pragma unroll
        for (int ct = 0; ct < 8; ++ct)
#pragma unroll
            for (int j = 0; j < 4; ++j) { const int so = 16 * w + 4 * quad + j, c = 128 * h + 16 * ct + fr; const size_t row = (size_t)row0 + so;
                const float z = bf2f(F.UB()[row * DB + c]) * (acc[ct][j] + F.spb()[h * 128 + so]); F.AZ()[row * DM + 512 + c] = (bf16)f2bf(z); }
        __syncthreads();
    }
}
__device__ __forceinline__ void gmlp_sample(Frame& F) {
    const int lane = F.lane;
    for (int rr = 0; rr < 4; ++rr) { const int s = 4 * F.wave + rr; const size_t row = (size_t)MP + s; const v4u raw = *(const v4u*)(F.VB() + row * DB + 8 * lane);
        float x[8] = {bflo(raw.x), bfhi(raw.x), bflo(raw.y), bfhi(raw.y), bflo(raw.z), bfhi(raw.z), bflo(raw.w), bfhi(raw.w)}; float sm = 0.f;
#pragma unroll
        for (int i = 0; i < 8; ++i) sm += x[i];
        const float mean = wave_sum(sm) * (1.f / DB); float s2 = 0.f;
#pragma unroll
        for (int i = 0; i < 8; ++i) { const float d = x[i] - mean; s2 += d * d; }
        const float rstd = 1.f / sqrtf(wave_sum(s2) * (1.f / DB) + LN_EPS);
        const int h = lane >> 4; const float w00 = F.spw()[(size_t)h * 128 * 128], b0 = F.spb()[h * 128];
#pragma unroll
        for (int i = 0; i < 8; ++i) { const int c = 8 * lane + i; const float vn = (x[i] - mean) * rstd * F.glg()[c] + F.glb()[c];
            F.out[O_SCH + (size_t)s * DB + c] = vn; F.AZ()[row * DM + 512 + c] = (bf16)f2bf(bf2f(F.UB()[row * DB + c]) * (w00 * vn + b0)); } }
}
__device__ __forceinline__ void cmp2_phase(Frame& F) {
    const int gw = F.vcu * NWAVES + F.wave, NGW = F.G * NWAVES, lane = F.lane, r32 = lane & 31, hi = lane >> 5;
    constexpr int PER = 8 * 16 + 64 * 32;
    for (int it = gw; it < 2 * PER; it += NGW) {
        const int kv = it / PER; int r = it % PER; int bg, i0, NS; const float* Hb; bf16* Ob;
        if (r < 128) { bg = r >> 4; i0 = (r & 15) * 32; NS = 512; Hb = F.HCP() + (size_t)kv * 4096 * 256; Ob = F.KCP() + (size_t)kv * 8 * 512 * 64; }
        else { r -= 128; bg = r >> 5; i0 = (r & 31) * 32; NS = 1024; Hb = F.HCS() + (size_t)kv * 65536 * 256; Ob = F.KCS() + (size_t)kv * 64 * 1024 * 64; }
        const int i = i0 + r32; const bool live = i < NS - 1;
        const float* h0 = Hb + ((size_t)bg * NS + i) * 256; const float* h1 = h0 + 256 + 128; const float* bias = F.CBIAS() + kv * 128; const bf16* w2 = F.W2T() + kv * 64 * 128;
        f32x16 a0 = {}, a1 = {};
#pragma unroll
        for (int ks = 0; ks < 8; ++ks) { const int k = 16 * ks + 8 * hi; float hv[8];
            if (live) { const f32x4 p0 = *(const f32x4*)(h0 + k), p1 = *(const f32x4*)(h0 + k + 4), q0 = *(const f32x4*)(h1 + k), q1 = *(const f32x4*)(h1 + k + 4), c0 = *(const f32x4*)(bias + k), c1 = *(const f32x4*)(bias + k + 4);
#pragma unroll
                for (int j = 0; j < 4; ++j) { hv[j] = gelu_tanh_(p0[j] + q0[j] + c0[j]); hv[4 + j] = gelu_tanh_(p1[j] + q1[j] + c1[j]); } }
            else {
#pragma unroll
                for (int j = 0; j < 8; ++j) hv[j] = 0.f; }
            v4u aw; aw.x = pk2(hv[0], hv[1]); aw.y = pk2(hv[2], hv[3]); aw.z = pk2(hv[4], hv[5]); aw.w = pk2(hv[6], hv[7]); const bf16x8 a = __builtin_bit_cast(bf16x8, aw);
            const bf16x8 b0 = *(const bf16x8*)(w2 + (size_t)r32 * 128 + k), b1 = *(const bf16x8*)(w2 + (size_t)(32 + r32) * 128 + k);
            a0 = MFMA32(a, b0, a0); a1 = MFMA32(a, b1, a1); }
#pragma unroll
        for (int x = 0; x < 16; ++x) { const size_t o = ((size_t)bg * NS + i0 + crow(x, hi)) * 64 + r32; Ob[o] = (bf16)f2bf(a0[x]); Ob[o + 32] = (bf16)f2bf(a1[x]); }
    }
}
__device__ __forceinline__ void ld16(const bf16* p, float (&x)[16]) {
#pragma unroll
    for (int j = 0; j < 2; ++j) { const v4u r = *(const v4u*)(p + 8 * j); x[8 * j] = bflo(r.x); x[8 * j + 1] = bfhi(r.x); x[8 * j + 2] = bflo(r.y); x[8 * j + 3] = bfhi(r.y); x[8 * j + 4] = bflo(r.z); x[8 * j + 5] = bfhi(r.z); x[8 * j + 6] = bflo(r.w); x[8 * j + 7] = bfhi(r.w); }
}
__device__ __forceinline__ void ld16(const float* p, float (&x)[16]) {
#pragma unroll
    for (int j = 0; j < 4; ++j) { const f32x4 r = *(const f32x4*)(p + 4 * j); x[4 * j] = r[0]; x[4 * j + 1] = r[1]; x[4 * j + 2] = r[2]; x[4 * j + 3] = r[3]; }
}
__device__ __forceinline__ float ld_el(const bf16* p, int d) { return bf2f(p[d]); }
__device__ __forceinline__ float ld_el(const float* p, int d) { return p[d]; }
template <class T> __device__ __forceinline__ void dot4_row(const LAS float* qs, const T* row, float (&s)[4]) {
    float a0 = 0.f, a1 = 0.f, a2 = 0.f, a3 = 0.f;
#pragma unroll
    for (int qd = 0; qd < 4; ++qd) { float x[16]; ld16(row + 16 * qd, x);
#pragma unroll
        for (int e = 0; e < 4; ++e) { const int d4 = 4 * qd + e; const f32x4 q0 = *(const LAS f32x4*)(qs + 4 * d4), q1 = *(const LAS f32x4*)(qs + 64 + 4 * d4), q2 = *(const LAS f32x4*)(qs + 128 + 4 * d4), q3 = *(const LAS f32x4*)(qs + 192 + 4 * d4);
            a0 += q0[0] * x[4 * e] + q0[1] * x[4 * e + 1] + q0[2] * x[4 * e + 2] + q0[3] * x[4 * e + 3];
            a1 += q1[0] * x[4 * e] + q1[1] * x[4 * e + 1] + q1[2] * x[4 * e + 2] + q1[3] * x[4 * e + 3];
            a2 += q2[0] * x[4 * e] + q2[1] * x[4 * e + 1] + q2[2] * x[4 * e + 2] + q2[3] * x[4 * e + 3];
            a3 += q3[0] * x[4 * e] + q3[1] * x[4 * e + 1] + q3[2] * x[4 * e + 2] + q3[3] * x[4 * e + 3]; }
        asm volatile("" : "+v"(a0), "+v"(a1), "+v"(a2), "+v"(a3) :: "memory"); }
    s[0] = a0; s[1] = a1; s[2] = a2; s[3] = a3;
}
template <bool SAMPLE, int BR, int KV> struct RowSrc;
template <int BR, int KV> struct RowSrc<false, BR, KV> { typedef bf16 T;
    static __device__ __forceinline__ const bf16* get(const Frame& F, int b, int g, int p) { return F.KVB() + (size_t)(2 * BR + KV) * KVB_T + ((size_t)((b * 2 + g) * TSEQ + p)) * 64; } };
template <int KV> struct RowSrc<true, 1, KV> { typedef float T;
    static __device__ __forceinline__ const float* get(const Frame& F, int b, int g, int p) {
        if (p >= PASTL) return F.KVS() + ((2 + KV) * 32 + b) * 128 + g * 64;
        return (KV ? F.csv() : F.csk()) + ((size_t)F.pt()[b * NPAGE + (p >> 7)] * 128 + (p & 127)) * 128 + g * 64; } };
template <int KV> struct RowSrc<true, 2, KV> { typedef float T;
    static __device__ __forceinline__ const float* get(const Frame& F, int b, int g, int p) {
        if (p >= PASTL) return F.KVS() + ((4 + KV) * 32 + b) * 128 + g * 64;
        return (KV ? F.cwv() : F.cwk()) + ((size_t)(b * 512 + (p - (PASTL - 512))) * 2 + g) * 64; } };

template <bool SAMPLE, int BR>
__device__ __forceinline__ void online_chunk(const Frame& F, int b, int g, int t, int p0, int lo, int hi_, const float (&slope)[4], const LAS float* qs, LAS float* pch, float (&m)[4], float (&l)[4], float (&o)[4], int lane) {
    const int p = p0 + lane; const bool v = (p >= lo) && (p <= hi_);
    const unsigned long long mask = __ballot(v);
    if (mask == 0ull) return;
    float s[4];
    if (v) { dot4_row(qs, RowSrc<SAMPLE, BR, 0>::get(F, b, g, p), s);
#pragma unroll
        for (int r = 0; r < 4; ++r) s[r] -= slope[r] * (float)(t - p); }
    else {
#pragma unroll
        for (int r = 0; r < 4; ++r) s[r] = -1e30f; }
#pragma unroll
    for (int r = 0; r < 4; ++r) { const float cm = wave_max(s[r]), mn = fmaxf(m[r], cm), sc_ = __expf(m[r] - mn), pr = v ? __expf(s[r] - mn) : 0.f;
        l[r] = l[r] * sc_ + wave_sum(pr); o[r] *= sc_; m[r] = mn; pch[r * 64 + lane] = pr; }
    LDS_WAIT(); asm volatile("" ::: "memory");
#pragma unroll 2
    for (int j = 0; j < 64; ++j) { if (!((mask >> j) & 1ull)) continue;
        const float vv = ld_el(RowSrc<SAMPLE, BR, 1>::get(F, b, g, p0 + j), lane);
#pragma unroll
        for (int r = 0; r < 4; ++r) o[r] += pch[r * 64 + j] * vv; }
    LDS_WAIT(); asm volatile("" ::: "memory");
}

template <bool SAMPLE>
__device__ __forceinline__ void naive_attn_item(const Frame& F, int b, int g, int t, size_t rowg, LAS float* wl) {
    const int lane = F.lane;
    LAS float* qs = wl; LAS float* pch = wl + 256; LAS float* psum = wl + 512; LAS float* sc = wl + 1600; LAS int* sel = (LAS int*)(wl + 1920);
    constexpr int NSEL = SAMPLE ? 257 : 128, NCMAX = SAMPLE ? 1023 : 511, NS = SAMPLE ? 1024 : 512, NPS = 4 * NSEL + 8;
    const int bg = b * 2 + g;
    for (int e = lane; e < 256; e += 64) qs[e] = bf2f(F.QB()[rowg * QW + g * 256 + e]);
    for (int e = lane; e < NPS; e += 64) psum[e] = 0.f;
    float slope[4];
#pragma unroll
    for (int r = 0; r < 4; ++r) slope[r] = exp2f(-(float)(g * 4 + r + 1));
    LDS_WAIT(); asm volatile("" ::: "memory");
    int nvalid = t >= 31 ? (t - 31) / 16 + 1 : 0; if (nvalid > NCMAX) nvalid = NCMAX;
    const bf16* kc = (SAMPLE ? F.KCS() : F.KCP()) + (size_t)bg * NS * 64; const bf16* vc = kc + (SAMPLE ? (size_t)64 * 1024 * 64 : (size_t)8 * 512 * 64);
    float mc[4], lc[4], oc[4];
#pragma unroll
    for (int r = 0; r < 4; ++r) { mc[r] = -1e30f; lc[r] = 0.f; oc[r] = 0.f; }
#pragma unroll 1
    for (int i0 = 0; i0 < nvalid; i0 += 64) { const int i = i0 + lane; const bool v = i < nvalid; float s[4];
        if (v) { dot4_row(qs, kc + (size_t)i * 64, s);
#pragma unroll
            for (int r = 0; r < 4; ++r) s[r] -= slope[r] * (float)(t - (16 * i + 31)); }
        else {
#pragma unroll
            for (int r = 0; r < 4; ++r) s[r] = -1e30f; }
#pragma unroll
        for (int r = 0; r < 4; ++r) { const float cm = wave_max(s[r]), mn = fmaxf(mc[r], cm); lc[r] = lc[r] * __expf(mc[r] - mn) + wave_sum(v ? __expf(s[r] - mn) : 0.f); mc[r] = mn; } }
#pragma unroll 1
    for (int i0 = 0; i0 < nvalid; i0 += 64) { const int i = i0 + lane; const bool v = i < nvalid; float pr[4];
        if (v) { float s[4]; dot4_row(qs, kc + (size_t)i * 64, s);
#pragma unroll
            for (int r = 0; r < 4; ++r) pr[r] = __expf(s[r] - slope[r] * (float)(t - (16 * i + 31)) - mc[r]) / lc[r];
            psum[i] = (pr[0] + pr[1]) + (pr[2] + pr[3]); }
        else {
#pragma unroll
            for (int r = 0; r < 4; ++r) pr[r] = 0.f; }
#pragma unroll
        for (int r = 0; r < 4; ++r) pch[r * 64 + lane] = pr[r];
        LDS_WAIT(); asm volatile("" ::: "memory");
        const int nj = (nvalid - i0) < 64 ? (nvalid - i0) : 64;
#pragma unroll 2
        for (int j = 0; j < nj; ++j) { const float vv = bf2f(vc[(size_t)(i0 + j) * 64 + lane]);
#pragma unroll
            for (int r = 0; r < 4; ++r) oc[r] += pch[r * 64 + j] * vv; }
        LDS_WAIT(); asm volatile("" ::: "memory"); }
    const int cur = t >> 6;
    for (int j = lane; j < NSEL; j += 64) { float im = 0.f;
#pragma unroll
        for (int o = -1; o < 4; ++o) { const int i = 4 * j + o; if (i >= 0) im += psum[i]; }
        const bool valid = (j * 64) <= t, forced = (j == 0) || (j == cur) || (j == cur - 1);
        sc[j] = valid ? (forced ? 1e4f : im) : -1e30f; }
    LDS_WAIT(); asm volatile("" ::: "memory");
    int nsel_found = 0;
    for (int j0 = 0; j0 < NSEL; j0 += 64) { const int j = j0 + lane; bool s_ = false;
        if (j < NSEL) { const float sj = sc[j]; int c = 0;
#pragma unroll 4
            for (int i = 0; i < NSEL; ++i) { const float si = sc[i]; c += ((si > sj) || (si == sj && i < j)) ? 1 : 0; }
            s_ = c < 16; }
        const unsigned long long mk = __ballot(s_);
        if (s_) { const int pos = nsel_found + __popcll(mk & ((1ull << lane) - 1ull)); if (pos < 16) sel[pos] = j; }
        nsel_found += __popcll(mk); }
    LDS_WAIT(); asm volatile("" ::: "memory");
    float ms[4], ls[4], os[4], mw[4], lw[4], ow[4];
#pragma unroll
    for (int r = 0; r < 4; ++r) { ms[r] = -1e30f; ls[r] = 0.f; os[r] = 0.f; mw[r] = -1e30f; lw[r] = 0.f; ow[r] = 0.f; }
    const int nk = nsel_found < 16 ? nsel_found : 16;
#pragma unroll 1
    for (int k = 0; k < nk; ++k) { const int blk = __builtin_amdgcn_readfirstlane(sel[k]); online_chunk<SAMPLE, 1>(F, b, g, t, blk * 64, 0, t, slope, qs, pch, ms, ls, os, lane); }
#pragma unroll 1
    for (int c = 0; c < 8; ++c) online_chunk<SAMPLE, 2>(F, b, g, t, t - 511 + 64 * c, (t - 511) > 0 ? (t - 511) : 0, t, slope, qs, pch, mw, lw, ow, lane);
    const float* gt = F.GT() + rowg * 24 + g * 12;
#pragma unroll
    for (int r = 0; r < 4; ++r) { const float o = gt[3 * r] * oc[r] + gt[3 * r + 1] * (ls[r] > 0.f ? os[r] / ls[r] : 0.f) + gt[3 * r + 2] * (lw[r] > 0.f ? ow[r] / lw[r] : 0.f);
        F.AZ()[rowg * DM + g * 256 + r * 64 + lane] = (bf16)f2bf(o); }
}
__device__ __forceinline__ void attn_naive_phase(Frame& F) {
    LAS float* wl = (LAS float*)(F.lds + RING_OFF + F.wave * 8192);
    const int gw = blockIdx.x * NWAVES + F.wave, NGW = F.G * NWAVES;
    for (int it = gw; it < MS * 2; it += NGW) { const int b = it >> 1, g = it & 1; naive_attn_item<true>(F, b, g, PASTL, (size_t)MP + b, wl); }
    for (int it = gw; it < MP * 2; it += NGW) { const int bg = it >> 13, t = it & 8191, b = bg >> 1, g = bg & 1; naive_attn_item<false>(F, b, g, t, (size_t)b * TSEQ + t, wl); }
}
#ifndef MK_SPLIT
#define MK_SPLIT 0
#endif
constexpr int N_PHASES = 15;
struct Args { const void* in[33]; float* out; unsigned char* ws; int ph_lo, ph_hi; };
__global__ void __launch_bounds__(NWAVES * 64, 2) nsa_fwd(Args args) {
    extern __shared__ __attribute__((aligned(16))) unsigned char lds[];
    Frame F;
    F.lds = (LAS unsigned char*)lds;
    F.MISC = (volatile LAS unsigned*)(F.lds + MISC_OFF);
    F.tid = threadIdx.x; F.lane = F.tid & 63; F.wave = __builtin_amdgcn_readfirstlane(F.tid >> 6);
    F.G = gridDim.x; { const int bx = blockIdx.x; F.vcu = (F.G % 8 == 0) ? (bx % 8) * (F.G / 8) + bx / 8 : bx; }
    unsigned char* ws = args.ws; F.ws = ws; F.out = args.out;
    F.ctl = (gu32*)(ws + WS_CTL);
    for (int u = F.tid; u < (LDS_BYTES - LDSCTL_OFF) / 4; u += NWAVES * 64) ((LAS unsigned*)(F.lds + LDSCTL_OFF))[u] = 0u;
    __syncthreads();
    XcdBarrier bar; bar.bar = (unsigned*)(F.ctl + CW_BAR); bar.x = 0; bar.st = nullptr;
    if (!MK_SPLIT) bar = xcd_barrier_post((unsigned*)(F.ctl + CW_BAR), F.MISC + 8);
    const int lo = args.ph_lo, hi = args.ph_hi;
#ifndef PH_MASK
#define PH_MASK 0x7fff
#endif
#define IN(k) (((PH_MASK >> (k)) & 1) && lo <= (k) && (k) < hi)
#define SEAM(k) do { if (IN(k) && IN((k) + 1)) xcd_barrier(bar); } while (0)
    LAS unsigned char* ring = F.lds + RING_OFF;
    const int bx = (int)blockIdx.x;

    if (IN(0)) { p0_prologue(F); }
    SEAM(0);
    if (IN(1)) {
#pragma unroll
        for (int kv = 0; kv < 2; ++kv) { pg8::Gemm g{F.SC() + (size_t)kv * 65536 * 1024, F.CW1() + (size_t)kv * 256 * DM, DM, DM, 16}; pg8::StaticOrder S; S.init(256, 1, F.G, bx);
            EpiF32 E{F.HCS() + (size_t)kv * 65536 * 256, 256}; pg8::gemm_phase<EpiF32, pg8::StaticOrder, true, true>(ring, g, S, E); }
    }
    SEAM(1);
    if (IN(2)) { sk_ffn_in(F, F.XB() + (size_t)MP * DM, F.W1IN());
        pg8::Gemm g{F.XB(), F.W1IN(), DM, DM, 16}; pg8::StaticOrder S; S.init(128, 22, F.G, bx); EpiSwiglu E{F.ACT()}; pg8::gemm_phase<EpiSwiglu, pg8::StaticOrder, true, true>(ring, g, S, E); }
    SEAM(2);
    if (IN(3)) { sk_resid(F, F.ACT() + (size_t)MP * FF, FF, F.W1OUT(), FF, 22, F.xs(), ALPHA, 0.5f);
        pg8::Gemm g{F.ACT(), F.W1OUT(), FF, FF, 44}; pg8::StaticOrder S; S.init(128, 4, F.G, bx); EpiResid E{F.x(), F.PRE(), ALPHA, 0.5f}; pg8::gemm_phase<EpiResid, pg8::StaticOrder, true, true>(ring, g, S, E); }
    SEAM(3);
    if (IN(4)) ln_phase(F, F.PRE(), F.ln1g(), F.ln1b(), F.H(), F.H() + (size_t)MP * DM, F.HB());
    SEAM(4);
    if (IN(5)) { sk_proj(F);
        pg8::Gemm g{F.HB(), F.WIN(), DM, DM, 16}; pg8::StaticOrder S; S.init(128, 18, F.G, bx); EpiProj E{F.QB(), F.KVB(), F.UB(), F.VB(), F.SGA(), F.SGB(), F.GT(), F.out}; pg8::gemm_phase<EpiProj, pg8::StaticOrder, true, true>(ring, g, S, E); }
    SEAM(5);
    if (IN(6)) {
        for (int c = bx; c < MP / 128; c += F.G) gmlp_chunk(F, c);
        if (bx == F.G - 1) gmlp_sample(F);
        __syncthreads();
#pragma unroll
        for (int kv = 0; kv < 2; ++kv) { pg8::Gemm g{F.KVB() + (size_t)kv * KVB_T, F.CW1() + (size_t)kv * 256 * DM, DM, DM, 16}; pg8::StaticOrder S; S.init(16, 1, F.G, (bx + F.G - 32 - 16 * kv) % F.G);
            EpiF32 E{F.HCP() + (size_t)kv * 4096 * 256, 256}; pg8::gemm_phase<EpiF32, pg8::StaticOrder, true, true>(ring, g, S, E); }
    }
    SEAM(6);
    if (IN(7)) cmp2_phase(F);
    SEAM(7);
    if (IN(8)) attn_naive_phase(F);
    SEAM(8);
    if (IN(9)) { sk_merge(F);
        pg8::Gemm g{F.AZ(), F.WAB(), DM, DM, 16}; pg8::StaticOrder S; S.init(128, 4, F.G, bx); EpiMerge E{F.SGA(), F.SGB(), F.MB()}; pg8::gemm_phase<EpiMerge, pg8::StaticOrder, true, true>(ring, g, S, E); }
    SEAM(9);
    if (IN(10)) { sk_resid(F, F.MB() + (size_t)MP * DM, DM, F.WOUT(), DM, 8, F.H() + (size_t)MP * DM, ALPHA, 1.0f);
        pg8::Gemm g{F.MB(), F.WOUT(), DM, DM, 16}; pg8::StaticOrder S; S.init(128, 4, F.G, bx); EpiResid E{F.H(), F.PRE(), ALPHA, 1.0f}; pg8::gemm_phase<EpiResid, pg8::StaticOrder, true, true>(ring, g, S, E); }
    SEAM(10);
    if (IN(11)) ln_phase(F, F.PRE(), F.ln2g(), F.ln2b(), F.H(), F.H() + (size_t)MP * DM, F.HB());
    SEAM(11);
    if (IN(12)) { sk_ffn_in(F, F.HB() + (size_t)MP * DM, F.W2IN());
        pg8::Gemm g{F.HB(), F.W2IN(), DM, DM, 16}; pg8::StaticOrder S; S.init(128, 22, F.G, bx); EpiSwiglu E{F.ACT()}; pg8::gemm_phase<EpiSwiglu, pg8::StaticOrder, true, true>(ring, g, S, E); }
    SEAM(12);
    if (IN(13)) { sk_resid(F, F.ACT() + (size_t)MP * FF, FF, F.W2OUT(), FF, 22, F.H() + (size_t)MP * DM, ALPHA, 0.5f);
        pg8::Gemm g{F.ACT(), F.W2OUT(), FF, FF, 44}; pg8::StaticOrder S; S.init(128, 4, F.G, bx); EpiResid E{F.H(), F.PRE(), ALPHA, 0.5f}; pg8::gemm_phase<EpiResid, pg8::StaticOrder, true, true>(ring, g, S, E); }
    SEAM(13);
    if (IN(14)) ln_phase(F, F.PRE(), F.ln3g(), F.ln3b(), F.out + O_Y, F.out + O_YS, nullptr);
#undef IN
#undef SEAM
}

extern "C" void kernel_launch(void* const* d_in, const int* in_sizes, int n_in, void* d_out, int out_size, void* d_ws, size_t ws_size, hipStream_t stream) {
    static int grid = 0;
    if (grid == 0) {
        if (n_in != 33 || (size_t)out_size != O_END || ws_size < WS_END) { fprintf(stderr, "kernel_launch: unexpected shapes (n_in %d out %d ws %zu need %zu)\n", n_in, out_size, ws_size, (size_t)WS_END); grid = -1; return; }
        int dev = 0, cus = 0, per_cu = 0;
        if (hipGetDevice(&dev) != hipSuccess || hipDeviceGetAttribute(&cus, hipDeviceAttributeMultiprocessorCount, dev) != hipSuccess) { grid = -1; return; }
        if (hipFuncSetAttribute((const void*)nsa_fwd, hipFuncAttributeMaxDynamicSharedMemorySize, LDS_BYTES) != hipSuccess) { fprintf(stderr, "kernel_launch: hipFuncSetAttribute failed\n"); grid = -1; return; }
        if (hipOccupancyMaxActiveBlocksPerMultiprocessor(&per_cu, (const void*)nsa_fwd, NWAVES * 64, LDS_BYTES) != hipSuccess || per_cu < 1) { fprintf(stderr, "kernel_launch: occupancy query says %d\n", per_cu); }
        (void)hipGetLastError();
        grid = cus;
    }
    if (grid < 0) return;
    if (hipMemsetAsync((char*)d_ws + WS_CTL, 0, CTL_ZERO_BYTES, stream) != hipSuccess) return;
    Args a{};
    for (int i = 0; i < 33; ++i) a.in[i] = d_in[i];
    a.out = (float*)d_out; a.ws = (unsigned char*)d_ws;
#if MK_SPLIT
    for (int p = 0; p < N_PHASES; ++p) { a.ph_lo = p; a.ph_hi = p + 1; hipLaunchKernelGGL(nsa_fwd, dim3(grid), dim3(NWAVES * 64), LDS_BYTES, stream, a); }
#else
    a.ph_lo = 0; a.ph_hi = N_PHASES;
    hipLaunchKernelGGL(nsa_fwd, dim3(grid), dim3(NWAVES * 64), LDS_BYTES, stream, a);
#endif
}
```

```cpp
#include <hip/hip_runtime.h>
#include <cstdio>
#include <cstdint>
namespace pg8 {
#define PG8_LAS __attribute__((address_space(3)))
typedef unsigned short bf16_t;
typedef short bf16x8 __attribute__((ext_vector_type(8)));
typedef float f32x4 __attribute__((ext_vector_type(4)));
typedef unsigned u32x4 __attribute__((ext_vector_type(4)));
constexpr int BM = 256, BK = 64, HALF = 128, HTB = HALF * BK * 2  , STAGE_BYTES = 8 * HTB, NXCD = 8, WGM = 8;

__host__ __device__ __forceinline__ int lds_byte(int r, int c) { const int st = (r >> 4) * 2 + (c >> 5), rr = r & 15, cc = c & 31, ob = rr * 64 + cc * 2; return st * 1024 + (ob ^ (((ob >> 9) & 1) << 5)); }
__host__ __device__ __forceinline__ void stage_rc(int b, int& R, int& C) { const int st = b / 1024, sb = b % 1024, swz = sb ^ (((sb >> 9) & 1) << 5); R = (st >> 1) * 16 + swz / 64; C = (st & 1) * 32 + (swz % 64) / 2; }
__host__ __device__ __forceinline__ int perm32(int rho) { const int n = rho >> 4, i = rho & 15; return 8 * (i >> 2) + 4 * n + (i & 3); }

struct Unit { int pm, pn; };
struct Gemm { const bf16_t* A; const bf16_t* Bt; int lda, ldb, nt; };

struct StaticOrder {
    int nM, nN, nwg, G, c;
    __host__ __device__ void init(int nM_, int nN_, int G_, int c_) { nM = nM_; nN = nN_; nwg = nM * nN; G = G_; c = c_; }
    __host__ __device__ bool next(int i, Unit& u) const {
        const long L = (long)i * G + c; if (L >= nwg) return false;
        int wgid = (int)L; { const int q = nwg / NXCD, r = nwg % NXCD, xcd = wgid % NXCD, off = wgid / NXCD; wgid = (xcd < r ? xcd * (q + 1) : r * (q + 1) + (xcd - r) * q) + off; }
        const int nig = WGM * nN, gid = wgid / nig, fm = gid * WGM, gsz = (nM - fm) < WGM ? (nM - fm) : WGM;
        u.pm = fm + ((wgid % nig) % gsz); u.pn = (wgid % nig) / gsz; return true;
    }
};

__device__ __forceinline__ unsigned cvt_pk_bf16(float lo, float hi) { unsigned r; asm volatile("v_cvt_pk_bf16_f32 %0, %1, %2" : "=v"(r) : "v"(lo), "v"(hi)); return r; }

template <class Epi, class Sched, bool ALIGN_EPI = false, bool SP2 = false>
__device__ __forceinline__ void gemm_phase(PG8_LAS unsigned char* lds, const Gemm g, const Sched& S, const Epi& E) {
    const int tid = threadIdx.x, wid = __builtin_amdgcn_readfirstlane(tid >> 6), lane = tid & 63, wr = wid >> 2, wc = wid & 3, fr = lane & 15, fq = lane >> 4;
    const int nt = g.nt;
    unsigned voffA[2], voffB[2];
#pragma unroll
    for (int i = 0; i < 2; ++i) { int R, C; stage_rc(tid * 16 + i * 8192, R, C); const int Rb = Epi::PERM ? ((R & ~31) + perm32(R & 31)) : R;
        voffA[i] = (unsigned)(R * g.lda + C) * 2u; voffB[i] = (unsigned)(Rb * g.ldb + C) * 2u; }
    const size_t kstep = (size_t)(BK * 2);
    const size_t hstepA = (size_t)HALF * g.lda * 2, hstepB = (size_t)HALF * g.ldb * 2;
    const size_t tstepA = 2 * hstepA, tstepB = 2 * hstepB;
    const unsigned ldsw = (unsigned)wid * 1024u;
    const int aoff = lds_byte(wr * 64 + fr, fq * 8), boff = lds_byte(wc * 32 + fr, fq * 8);
#define PG8_SA(b, h) (((b) * 2 + (h)) * HTB)
#define PG8_SB(b, h) ((4 + (b) * 2 + (h)) * HTB)
#define PG8_STAGE(bufoff, gbase, voff) do { _Pragma("unroll") for (int _i = 0; _i < 2; ++_i) \
        __builtin_amdgcn_global_load_lds((const unsigned*)((const char*)(gbase) + (voff)[_i]), (PG8_LAS unsigned*)(lds + (bufoff) + ldsw + _i * 8192), 16, 0, 0); } while (0)
#define PG8_LDA(dst, b, h) do { _Pragma("unroll") for (int m = 0; m < 4; ++m) _Pragma("unroll") for (int k = 0; k < 2; ++k) dst[m][k] = *(const PG8_LAS bf16x8*)(lds + PG8_SA(b, h) + aoff + m * 2048 + k * 1024); } while (0)
#define PG8_LDB(dst, b, h) do { _Pragma("unroll") for (int n = 0; n < 2; ++n) _Pragma("unroll") for (int k = 0; k < 2; ++k) dst[n][k] = *(const PG8_LAS bf16x8*)(lds + PG8_SB(b, h) + boff + n * 2048 + k * 1024); } while (0)
#define PG8_MMA(ai, bj, At, Bt) do { __builtin_amdgcn_s_setprio(1); _Pragma("unroll") for (int m = 0; m < 4; ++m) _Pragma("unroll") for (int n = 0; n < 2; ++n) _Pragma("unroll") for (int k = 0; k < 2; ++k) \
        acc[ai][bj][m][n] = __builtin_amdgcn_mfma_f32_16x16x32_bf16(Bt[n][k], At[m][k], acc[ai][bj][m][n], 0, 0, 0); __builtin_amdgcn_s_setprio(0); } while (0)
#define PG8_WAIT_V(n) asm volatile("s_waitcnt vmcnt(" #n ")" ::: "memory")
#define PG8_WAIT_L(n) asm volatile("s_waitcnt lgkmcnt(" #n ")" ::: "memory")
#define PG8_BAR __builtin_amdgcn_s_barrier()
#define PG8_SCHED __builtin_amdgcn_sched_barrier(0)
    Unit cur, nxt; int ui = 0;
    if (!S.next(0, cur)) return;
    f32x4 acc[2][2][4][2];
#pragma unroll
    for (int a = 0; a < 2; ++a)
#pragma unroll
        for (int b = 0; b < 2; ++b)
#pragma unroll
            for (int m = 0; m < 4; ++m)
#pragma unroll
                for (int n = 0; n < 2; ++n) acc[a][b][m][n] = (f32x4){0.f, 0.f, 0.f, 0.f};
    bf16x8 At[4][2], B0[2][2], B1[2][2];
    const char* cA = (const char*)g.A + (size_t)cur.pm * tstepA; const char* cB = (const char*)g.Bt + (size_t)cur.pn * tstepB;
    if constexpr (SP2) {
        PG8_STAGE(PG8_SB(0, 0), cB, voffB); PG8_STAGE(PG8_SB(0, 1), cB + hstepB, voffB); PG8_STAGE(PG8_SA(0, 0), cA, voffA); PG8_STAGE(PG8_SA(0, 1), cA + hstepA, voffA);
        if (wr == 1) PG8_BAR;
        PG8_WAIT_V(2); PG8_BAR;
        PG8_STAGE(PG8_SB(1, 0), cB + kstep, voffB); PG8_STAGE(PG8_SA(1, 0), cA + kstep, voffA); PG8_STAGE(PG8_SB(1, 1), cB + hstepB + kstep, voffB);
        PG8_WAIT_V(6); PG8_BAR;
    } else {
        PG8_STAGE(PG8_SB(0, 0), cB, voffB); PG8_STAGE(PG8_SA(0, 0), cA, voffA); PG8_STAGE(PG8_SB(0, 1), cB + hstepB, voffB); PG8_STAGE(PG8_SA(0, 1), cA + hstepA, voffA);
        if (wr == 1) PG8_BAR;
        PG8_WAIT_V(4); PG8_BAR;
        PG8_STAGE(PG8_SB(1, 0), cB + kstep, voffB); PG8_STAGE(PG8_SA(1, 0), cA + kstep, voffA); PG8_STAGE(PG8_SB(1, 1), cB + hstepB + kstep, voffB);
        PG8_WAIT_V(6); PG8_BAR;
    }
    for (;;) {
        const bool has_next = S.next(ui + 1, nxt);
        const char* nA = has_next ? (const char*)g.A + (size_t)nxt.pm * tstepA : cA; const char* nB = has_next ? (const char*)g.Bt + (size_t)nxt.pn * tstepB : cB;
        for (int t = 0; t < nt; t += 2) {
            const bool last = (t == nt - 2);
            const char* a1 = cA + (size_t)(t + 1) * kstep;
            const char* a2 = last ? nA : cA + (size_t)(t + 2) * kstep; const char* b2 = last ? nB : cB + (size_t)(t + 2) * kstep;
            const char* a3 = a2 + kstep; const char* b3 = b2 + kstep;
            if constexpr (Epi::MIDK) { if (t == (nt >> 1)) E.mid(acc, cur, wr, wc, fr, fq); }
            if constexpr (SP2) {
            PG8_LDB(B0, 0, 0); PG8_LDB(B1, 0, 1); PG8_SCHED; PG8_LDA(At, 0, 0); PG8_STAGE(PG8_SA(1, 1), a1 + hstepA, voffA);
            PG8_WAIT_V(8); PG8_WAIT_L(0); PG8_BAR; PG8_MMA(0, 0, At, B0); PG8_MMA(0, 1, At, B1); PG8_BAR; PG8_SCHED;
            PG8_LDA(At, 0, 1); PG8_STAGE(PG8_SB(0, 0), b2, voffB); PG8_STAGE(PG8_SB(0, 1), b2 + hstepB, voffB); PG8_STAGE(PG8_SA(0, 0), a2, voffA);
            PG8_WAIT_V(8); PG8_WAIT_L(0); PG8_BAR; PG8_MMA(1, 0, At, B0); PG8_MMA(1, 1, At, B1); PG8_BAR; PG8_SCHED;
            PG8_LDB(B0, 1, 0); PG8_LDB(B1, 1, 1); PG8_SCHED; PG8_LDA(At, 1, 0); PG8_STAGE(PG8_SA(0, 1), a2 + hstepA, voffA);
            PG8_WAIT_V(8); PG8_WAIT_L(0); PG8_BAR; PG8_MMA(0, 0, At, B0); PG8_MMA(0, 1, At, B1); PG8_BAR; PG8_SCHED;
            PG8_LDA(At, 1, 1); PG8_STAGE(PG8_SB(1, 0), b3, voffB); PG8_STAGE(PG8_SB(1, 1), b3 + hstepB, voffB); PG8_STAGE(PG8_SA(1, 0), a3, voffA);
            PG8_WAIT_V(8); PG8_WAIT_L(0); PG8_BAR; PG8_MMA(1, 0, At, B0); PG8_MMA(1, 1, At, B1); PG8_BAR; PG8_SCHED;
            } else {
            PG8_LDB(B0, 0, 0); PG8_SCHED; PG8_LDA(At, 0, 0); PG8_STAGE(PG8_SA(1, 1), a1 + hstepA, voffA);
            PG8_WAIT_L(8); PG8_BAR; PG8_WAIT_L(0); PG8_MMA(0, 0, At, B0); PG8_BAR; PG8_SCHED;
            PG8_LDB(B1, 0, 1); PG8_STAGE(PG8_SB(0, 0), b2, voffB);
            PG8_BAR; PG8_WAIT_L(0); PG8_MMA(0, 1, At, B1); PG8_BAR;
            PG8_LDA(At, 0, 1); PG8_STAGE(PG8_SA(0, 0), a2, voffA);
            PG8_BAR; PG8_WAIT_L(0); PG8_MMA(1, 0, At, B0); PG8_BAR; PG8_SCHED;
            PG8_STAGE(PG8_SB(0, 1), b2 + hstepB, voffB);
            PG8_WAIT_V(6); PG8_BAR; PG8_MMA(1, 1, At, B1); PG8_BAR;
            PG8_LDB(B0, 1, 0); PG8_SCHED; PG8_LDA(At, 1, 0); PG8_STAGE(PG8_SA(0, 1), a2 + hstepA, voffA);
            PG8_WAIT_L(8); PG8_BAR; PG8_WAIT_L(0); PG8_MMA(0, 0, At, B0); PG8_BAR; PG8_SCHED;
            PG8_LDB(B1, 1, 1); PG8_STAGE(PG8_SB(1, 0), b3, voffB);
            PG8_BAR; PG8_WAIT_L(0); PG8_MMA(0, 1, At, B1); PG8_BAR;
            PG8_LDA(At, 1, 1); PG8_STAGE(PG8_SA(1, 0), a3, voffA);
            PG8_BAR; PG8_WAIT_L(0); PG8_MMA(1, 0, At, B0); PG8_BAR; PG8_SCHED;
            PG8_STAGE(PG8_SB(1, 1), b3 + hstepB, voffB);
            PG8_WAIT_V(6); PG8_BAR; PG8_MMA(1, 1, At, B1); PG8_BAR;
            }
        }
        if constexpr (ALIGN_EPI) { if (wr == 0) PG8_BAR; }
        E(acc, cur, wr, wc, fr, fq);
        if (!has_next) break;
#pragma unroll
        for (int a = 0; a < 2; ++a)
#pragma unroll
            for (int b = 0; b < 2; ++b)
#pragma unroll
                for (int m = 0; m < 4; ++m)
#pragma unroll
                    for (int n = 0; n < 2; ++n) acc[a][b][m][n] = (f32x4){0.f, 0.f, 0.f, 0.f};
        cur = nxt; cA = nA; cB = nB; ++ui;
        if constexpr (ALIGN_EPI) { if (wr == 1) PG8_BAR; }
    }
    PG8_WAIT_V(0);
    if constexpr (!ALIGN_EPI) { if (wr == 0) PG8_BAR; }
    PG8_BAR;
#undef PG8_SA
#undef PG8_SB
#undef PG8_STAGE
#undef PG8_LDA
#undef PG8_LDB
#undef PG8_MMA
#undef PG8_WAIT_V
#undef PG8_WAIT_L
#undef PG8_BAR
#undef PG8_SCHED
}
}
constexpr int NWAVES = 8;
constexpr int DM = 1024, MP = 32768, MS = 32, MR = MP + 256, TSEQ = 8192, NB = 4;
constexpr int FF = 2816, NFF2 = 2 * FF, NPROJ = 4608, DB = 512, QW = 512;
constexpr int PASTL = 16384, NPAGE = 128;
constexpr float ALPHA = 1.189207115002721f;
constexpr float LN_EPS = 1e-5f;
constexpr float QSCALE = 0.125f * 1.4426950408889634f;
constexpr size_t O_Y = 0, O_YS = O_Y + (size_t)MP * DM, O_PCK = O_YS + (size_t)MS * DM, O_PCV = O_PCK + (size_t)MP * 128, O_PSK = O_PCV + (size_t)MP * 128, O_PSV = O_PSK + (size_t)MP * 128,
                 O_PWK = O_PSV + (size_t)MP * 128, O_PWV = O_PWK + (size_t)NB * 512 * 128, O_SCK = O_PWV + (size_t)NB * 512 * 128, O_SCV = O_SCK + MS * 128, O_SSK = O_SCV + MS * 128, O_SSV = O_SSK + MS * 128,
                 O_SWK = O_SSV + MS * 128, O_SWV = O_SWK + (size_t)MS * 512 * 128, O_SCH = O_SWV + (size_t)MS * 512 * 128, O_END = O_SCH + (size_t)MS * DB;
constexpr size_t MiB = 1u << 20;
constexpr size_t WS_CTL = 0, CTL_ZERO_BYTES = 1 * MiB;
constexpr size_t WS_W1IN = 2 * MiB, WS_W1OUT = 13 * MiB, WS_WIN = 19 * MiB, WS_WAB = 28 * MiB, WS_WOUT = 30 * MiB, WS_W2IN = 32 * MiB, WS_W2OUT = 43 * MiB, WS_CW1 = 49 * MiB  , WS_SMALL = 50 * MiB;
constexpr size_t ROWB2 = (size_t)MR * 2, ROWB4 = (size_t)MR * 4;
constexpr size_t WS_XB = 52 * MiB;
constexpr size_t WS_ACT = WS_XB + ROWB2 * DM + MiB;
constexpr size_t WS_PRE = WS_ACT + ROWB2 * FF + MiB;
constexpr size_t WS_SC = WS_ACT;
constexpr size_t WS_H = WS_PRE + ROWB4 * DM + MiB;
constexpr size_t WS_HB = WS_H + ROWB4 * DM + MiB;
constexpr size_t WS_QB = WS_HB + ROWB2 * DM + MiB;
constexpr size_t WS_KVB = WS_QB + ROWB2 * QW + MiB;
constexpr size_t KVB_T = (size_t)NB * 2 * TSEQ * 64;
constexpr size_t WS_AZ = WS_KVB + 6 * KVB_T * 2 + MiB;
constexpr size_t WS_UB = WS_AZ + ROWB2 * DM + MiB;
constexpr size_t WS_VB = WS_UB + ROWB2 * DB + MiB;
constexpr size_t WS_SGA = WS_VB + ROWB2 * DB + MiB;
constexpr size_t WS_SGB = WS_SGA + ROWB2 * DM + MiB;
constexpr size_t WS_GT = WS_SGB + ROWB2 * DM + MiB;
constexpr size_t WS_MB = WS_GT + ROWB4 * 24 + MiB;
constexpr size_t WS_KCP = WS_MB + ROWB2 * DM + MiB;
constexpr size_t WS_KCS = WS_KCP + 2 * 8 * 512 * 64 * 2 + MiB;
constexpr size_t WS_HCS = WS_KCS + (size_t)2 * 64 * 1024 * 64 * 2 + MiB;
constexpr size_t WS_HCP = WS_HCS + (size_t)2 * 65536 * 256 * 4 + MiB;
constexpr size_t WS_END = WS_HCP + (size_t)2 * 4096 * 256 * 4 + MiB;
static_assert(WS_SC + (size_t)2 * 65536 * 1024 * 2 <= WS_H, "sample cache overlay fits in ACT|PRE");
constexpr size_t SM_CBIAS = 0;
constexpr size_t SM_W2T = 4096;
constexpr size_t SM_KVS = 65536;
constexpr int CW_TMO = 0, CW_CODE = 1, CW_BAR = 4096;

constexpr int RING_OFF = 0, RING_BYTES = 139264;
constexpr int LDSCTL_OFF = RING_BYTES, MISC_OFF = LDSCTL_OFF + 320;
constexpr int LDS_BYTES = 147456;
static_assert(MISC_OFF + 128 <= LDS_BYTES, "LDS map");

#define GAS __attribute__((address_space(1)))
#define LAS __attribute__((address_space(3)))
typedef unsigned short bf16;
typedef unsigned v4u __attribute__((ext_vector_type(4)));
typedef unsigned v2u __attribute__((ext_vector_type(2)));
typedef float f32x4 __attribute__((ext_vector_type(4)));
typedef float f32x16 __attribute__((ext_vector_type(16)));
typedef short bf16x8 __attribute__((ext_vector_type(8)));
typedef GAS unsigned gu32;
#define RLX_AGENT __ATOMIC_RELAXED, __HIP_MEMORY_SCOPE_AGENT
#define LDS_WAIT() asm volatile("s_waitcnt lgkmcnt(0)" ::: "memory")
#define VM_WAIT() asm volatile("s_waitcnt vmcnt(0)" ::: "memory")
__device__ __forceinline__ unsigned f2bf(float f) { unsigned u = __builtin_bit_cast(unsigned, f); return (u + 0x7fffu + ((u >> 16) & 1u)) >> 16; }
__device__ __forceinline__ unsigned pk2(float lo, float hi) { return f2bf(lo) | (f2bf(hi) << 16); }
__device__ __forceinline__ float bf2f(unsigned v) { return __uint_as_float(v << 16); }
__device__ __forceinline__ float bflo(unsigned w) { return __uint_as_float(w << 16); }
__device__ __forceinline__ float bfhi(unsigned w) { return __uint_as_float(w & 0xffff0000u); }
__device__ __forceinline__ float sigmoidf_(float x) { return 1.0f / (1.0f + __expf(-x)); }
__device__ __forceinline__ float siluf_(float x) { return x / (1.0f + __expf(-x)); }
__device__ __forceinline__ float gelu_tanh_(float x) { const float u = 1.5957691216057308f * (x + 0.044715f * x * x * x); return x / (1.0f + __expf(-u)); }
__device__ __forceinline__ float wave_sum(float v) {
#pragma unroll
    for (int o = 1; o < 64; o <<= 1) v += __shfl_xor(v, o);
    return v;
}
__device__ __forceinline__ float wave_max(float v) {
#pragma unroll
    for (int o = 1; o < 64; o <<= 1) v = fmaxf(v, __shfl_xor(v, o));
    return v;
}

#define XB_TMO      128
#define XB_XCNT(j)  (256  + 64 * (j))
#define XB_XSUB(j)  (1280 + 64 * (j))
#define XB_XGEN(j)  (2304 + 64 * (j))
#define XB_TOP      3328
#define XB_TOPGEN   3392
#define XCD_BAR_WORDS 3456
#define XB_SPIN_CAP (1u << 18)

__device__ __forceinline__ unsigned xb_ld(unsigned* p)              { return __hip_atomic_load(p, __ATOMIC_RELAXED, __HIP_MEMORY_SCOPE_AGENT); }
__device__ __forceinline__ unsigned xb_add(unsigned* p, unsigned v) { return __hip_atomic_fetch_add(p, v, __ATOMIC_RELAXED, __HIP_MEMORY_SCOPE_AGENT); }
__device__ __forceinline__ unsigned xb_xcc_id() { return (unsigned)__builtin_amdgcn_s_getreg((3 << 11) | 20) & 0xFu; }
#define XB_SPIN(cond, bar) do { unsigned _sp = 0; while (cond) { __builtin_amdgcn_s_sleep(1); \
    if ((++_sp & 255u) == 0u) { if (xb_ld(&(bar)[XB_TMO])) break; if (_sp > XB_SPIN_CAP) { atomicAdd(&(bar)[XB_TMO], 1u); break; } } } } while (0)

struct XcdBarrier { unsigned* bar; unsigned x; volatile LAS unsigned* st; };

__device__ __forceinline__ XcdBarrier xcd_barrier_post(unsigned* bar, volatile LAS unsigned* st) {
    XcdBarrier b; b.bar = bar; b.x = xb_xcc_id(); b.st = st;
    if (threadIdx.x == 0) (void)xb_add(&bar[XB_XCNT(b.x)], 1u);
    return b;
}
__device__ __forceinline__ void xcd_barrier_complete(unsigned* bar, unsigned x, unsigned& nloc, unsigned& nx) {
    const unsigned G = gridDim.x * gridDim.y * gridDim.z;
    unsigned sum, cnt, mine, sp = 0u;
    for (;;) {
        sum = 0u; cnt = 0u; mine = 0u;
#pragma unroll
        for (unsigned j = 0; j < 16; ++j) { const unsigned c = xb_ld(&bar[XB_XCNT(j)]); sum += c; cnt += (c > 0u) ? 1u : 0u; mine = (j == x) ? c : mine; }
        if (sum == G) break;
        __builtin_amdgcn_s_sleep(1);
        if ((++sp & 255u) == 0u) { if (xb_ld(&bar[XB_TMO])) break; if (sp > XB_SPIN_CAP) { atomicAdd(&bar[XB_TMO], 1u); break; } }
    }
    nloc = mine > 0u ? mine : 1u; nx = cnt > 0u ? cnt : 1u;
}
__device__ __forceinline__ void xcd_barrier(const XcdBarrier& b) {
    asm volatile("s_waitcnt vmcnt(0)" ::: "memory");
    __syncthreads();
    if (threadIdx.x == 0) {
        unsigned* bar = b.bar;
        __builtin_amdgcn_s_waitcnt(0);
        unsigned nloc = b.st[0], nx = b.st[1];
        if (nloc == 0u) { xcd_barrier_complete(bar, b.x, nloc, nx); b.st[0] = nloc; b.st[1] = nx; }
        const unsigned old = xb_add(&bar[XB_XSUB(b.x)], 1u);
        const unsigned gen = old / nloc;
        if (old + 1u == (gen + 1u) * nloc) {
            __builtin_amdgcn_fence(__ATOMIC_RELEASE, "agent");
            asm volatile("s_waitcnt vmcnt(0)" ::: "memory");
            const unsigned og = xb_add(&bar[XB_TOP], 1u);
            const unsigned tg = og / nx;
            if (og + 1u == (tg + 1u) * nx) xb_add(&bar[XB_TOPGEN], 1u);
            else XB_SPIN(xb_ld(&bar[XB_TOPGEN]) == tg, bar);
            __builtin_amdgcn_fence(__ATOMIC_ACQUIRE, "agent");
            xb_add(&bar[XB_XGEN(b.x)], 1u);
            asm volatile("s_waitcnt vmcnt(0)" ::: "memory");
        } else {
            XB_SPIN(xb_ld(&bar[XB_XGEN(b.x)]) == gen, bar);
            __builtin_amdgcn_fence(__ATOMIC_ACQUIRE, "agent");
            asm volatile("s_waitcnt vmcnt(0)" ::: "memory");
        }
    }
    __syncthreads();
}

struct Frame {
    LAS unsigned char* lds;
    volatile LAS unsigned* MISC;
    gu32* ctl;
    int tid, lane, wave;
    int vcu, G;
    float* out; unsigned char* ws;
    __device__ __forceinline__ unsigned char* wsb_() const { unsigned char* p = ws; asm volatile("" : "+s"(p)); return p; }
    __device__ __forceinline__ const void* inp_(int k) const { const void* const* ka = (const void* const*)__builtin_amdgcn_kernarg_segment_ptr(); asm volatile("" : "+s"(ka)); return ka[k]; }
    __device__ __forceinline__ const float* x() const { return (const float*)inp_(0); }
    __device__ __forceinline__ const float* xs() const { return (const float*)inp_(1); }
    __device__ __forceinline__ const float* cck() const { return (const float*)inp_(2); }
    __device__ __forceinline__ const float* ccv() const { return (const float*)inp_(3); }
    __device__ __forceinline__ const float* csk() const { return (const float*)inp_(4); }
    __device__ __forceinline__ const float* csv() const { return (const float*)inp_(5); }
    __device__ __forceinline__ const float* cwk() const { return (const float*)inp_(6); }
    __device__ __forceinline__ const float* cwv() const { return (const float*)inp_(7); }
    __device__ __forceinline__ const int* pt() const { return (const int*)inp_(8); }
    __device__ __forceinline__ const float* f1wi() const { return (const float*)inp_(9); }
    __device__ __forceinline__ const float* f1wo() const { return (const float*)inp_(10); }
    __device__ __forceinline__ const float* ln1g() const { return (const float*)inp_(11); }
    __device__ __forceinline__ const float* ln1b() const { return (const float*)inp_(12); }
    __device__ __forceinline__ const float* win() const { return (const float*)inp_(13); }
    __device__ __forceinline__ const float* pek() const { return (const float*)inp_(14); }
    __device__ __forceinline__ const float* w1k() const { return (const float*)inp_(15); }
    __device__ __forceinline__ const float* w2k() const { return (const float*)inp_(16); }
    __device__ __forceinline__ const float* pev() const { return (const float*)inp_(17); }
    __device__ __forceinline__ const float* w1v() const { return (const float*)inp_(18); }
    __device__ __forceinline__ const float* w2v() const { return (const float*)inp_(19); }
    __device__ __forceinline__ const float* glg() const { return (const float*)inp_(20); }
    __device__ __forceinline__ const float* glb() const { return (const float*)inp_(21); }
    __device__ __forceinline__ const float* spw() const { return (const float*)inp_(22); }
    __device__ __forceinline__ const float* spb() const { return (const float*)inp_(23); }
    __device__ __forceinline__ const float* wa() const { return (const float*)inp_(24); }
    __device__ __forceinline__ const float* wb() const { return (const float*)inp_(25); }
    __device__ __forceinline__ const float* wout() const { return (const float*)inp_(26); }
    __device__ __forceinline__ const float* ln2g() const { return (const float*)inp_(27); }
    __device__ __forceinline__ const float* ln2b() const { return (const float*)inp_(28); }
    __device__ __forceinline__ const float* f2wi() const { return (const float*)inp_(29); }
    __device__ __forceinline__ const float* f2wo() const { return (const float*)inp_(30); }
    __device__ __forceinline__ const float* ln3g() const { return (const float*)inp_(31); }
    __device__ __forceinline__ const float* ln3b() const { return (const float*)inp_(32); }
    __device__ __forceinline__ bf16* W1IN() const { return (bf16*)(wsb_() + (WS_W1IN)); }
    __device__ __forceinline__ bf16* W1OUT() const { return (bf16*)(wsb_() + (WS_W1OUT)); }
    __device__ __forceinline__ bf16* WIN() const { return (bf16*)(wsb_() + (WS_WIN)); }
    __device__ __forceinline__ bf16* WAB() const { return (bf16*)(wsb_() + (WS_WAB)); }
    __device__ __forceinline__ bf16* WOUT() const { return (bf16*)(wsb_() + (WS_WOUT)); }
    __device__ __forceinline__ bf16* W2IN() const { return (bf16*)(wsb_() + (WS_W2IN)); }
    __device__ __forceinline__ bf16* W2OUT() const { return (bf16*)(wsb_() + (WS_W2OUT)); }
    __device__ __forceinline__ bf16* CW1() const { return (bf16*)(wsb_() + (WS_CW1)); }
    __device__ __forceinline__ bf16* XB() const { return (bf16*)(wsb_() + (WS_XB)); }
    __device__ __forceinline__ bf16* ACT() const { return (bf16*)(wsb_() + (WS_ACT)); }
    __device__ __forceinline__ bf16* HB() const { return (bf16*)(wsb_() + (WS_HB)); }
    __device__ __forceinline__ bf16* QB() const { return (bf16*)(wsb_() + (WS_QB)); }
    __device__ __forceinline__ bf16* KVB() const { return (bf16*)(wsb_() + (WS_KVB)); }
    __device__ __forceinline__ bf16* AZ() const { return (bf16*)(wsb_() + (WS_AZ)); }
    __device__ __forceinline__ bf16* UB() const { return (bf16*)(wsb_() + (WS_UB)); }
    __device__ __forceinline__ bf16* VB() const { return (bf16*)(wsb_() + (WS_VB)); }
    __device__ __forceinline__ bf16* SGA() const { return (bf16*)(wsb_() + (WS_SGA)); }
    __device__ __forceinline__ bf16* SGB() const { return (bf16*)(wsb_() + (WS_SGB)); }
    __device__ __forceinline__ bf16* MB() const { return (bf16*)(wsb_() + (WS_MB)); }
    __device__ __forceinline__ bf16* KCP() const { return (bf16*)(wsb_() + (WS_KCP)); }
    __device__ __forceinline__ bf16* KCS() const { return (bf16*)(wsb_() + (WS_KCS)); }
    __device__ __forceinline__ bf16* SC() const { return (bf16*)(wsb_() + (WS_SC)); }
    __device__ __forceinline__ bf16* W2T() const { return (bf16*)(wsb_() + (WS_SMALL + SM_W2T)); }
    __device__ __forceinline__ float* PRE() const { return (float*)(wsb_() + (WS_PRE)); }
    __device__ __forceinline__ float* H() const { return (float*)(wsb_() + (WS_H)); }
    __device__ __forceinline__ float* GT() const { return (float*)(wsb_() + (WS_GT)); }
    __device__ __forceinline__ float* HCS() const { return (float*)(wsb_() + (WS_HCS)); }
    __device__ __forceinline__ float* HCP() const { return (float*)(wsb_() + (WS_HCP)); }
    __device__ __forceinline__ float* CBIAS() const { return (float*)(wsb_() + (WS_SMALL + SM_CBIAS)); }
    __device__ __forceinline__ float* KVS() const { return (float*)(wsb_() + (WS_SMALL + SM_KVS)); }
};
using pg8::Unit;
struct EpiF32 {
    static constexpr bool PERM = false, MIDK = false;
    float* C; int ldc;
    __device__ __forceinline__ void operator()(const f32x4 (&acc)[2][2][4][2], const Unit& u, int wr, int wc, int fr, int fq) const {
        const int row0 = u.pm * 256 + wr * 64 + fr, col0 = u.pn * 256 + wc * 32 + 4 * fq;
#pragma unroll
        for (int ai = 0; ai < 2; ++ai)
#pragma unroll
            for (int m = 0; m < 4; ++m) { float* rowp = C + (size_t)(row0 + ai * 128 + m * 16) * ldc + col0;
#pragma unroll
                for (int bj = 0; bj < 2; ++bj)
#pragma unroll
                    for (int n = 0; n < 2; ++n) *(f32x4*)(rowp + bj * 128 + n * 16) = acc[ai][bj][m][n]; }
    }
};
struct EpiResid {
    static constexpr bool PERM = false, MIDK = false;
    const float* res; float* out; float a, b;
    __device__ __forceinline__ void operator()(const f32x4 (&acc)[2][2][4][2], const Unit& u, int wr, int wc, int fr, int fq) const {
        const int row0 = u.pm * 256 + wr * 64 + fr, col0 = u.pn * 256 + wc * 32 + 4 * fq;
#pragma unroll
        for (int ai = 0; ai < 2; ++ai)
#pragma unroll
            for (int m = 0; m < 4; ++m) { const size_t off = (size_t)(row0 + ai * 128 + m * 16) * DM + col0;
#pragma unroll
                for (int bj = 0; bj < 2; ++bj)
#pragma unroll
                    for (int n = 0; n < 2; ++n) { const f32x4 r = *(const f32x4*)(res + off + bj * 128 + n * 16); *(f32x4*)(out + off + bj * 128 + n * 16) = r * a + acc[ai][bj][m][n] * b; } }
    }
};
struct EpiSwiglu {
    static constexpr bool PERM = true, MIDK = false;
    bf16* O;
    __device__ __forceinline__ void operator()(const f32x4 (&acc)[2][2][4][2], const Unit& u, int wr, int wc, int fr, int fq) const {
        const int row0 = u.pm * 256 + wr * 64 + fr, col0 = u.pn * 128 + wc * 32 + 8 * fq;
#pragma unroll
        for (int ai = 0; ai < 2; ++ai)
#pragma unroll
            for (int m = 0; m < 4; ++m) { bf16* rowp = O + (size_t)(row0 + ai * 128 + m * 16) * FF + col0;
                const f32x4 g0 = acc[ai][0][m][0], g1 = acc[ai][0][m][1], u0 = acc[ai][1][m][0], u1 = acc[ai][1][m][1];
                v4u w; w.x = pg8::cvt_pk_bf16(siluf_(g0[0]) * u0[0], siluf_(g0[1]) * u0[1]); w.y = pg8::cvt_pk_bf16(siluf_(g0[2]) * u0[2], siluf_(g0[3]) * u0[3]);
                w.z = pg8::cvt_pk_bf16(siluf_(g1[0]) * u1[0], siluf_(g1[1]) * u1[1]); w.w = pg8::cvt_pk_bf16(siluf_(g1[2]) * u1[2], siluf_(g1[3]) * u1[3]);
                *(v4u*)rowp = w; }
    }
};
__device__ __forceinline__ v4u pack8(const f32x4 a, const f32x4 b) { v4u w; w.x = pg8::cvt_pk_bf16(a[0], a[1]); w.y = pg8::cvt_pk_bf16(a[2], a[3]); w.z = pg8::cvt_pk_bf16(b[0], b[1]); w.w = pg8::cvt_pk_bf16(b[2], b[3]); return w; }
struct EpiProj {
    static constexpr bool PERM = true, MIDK = false;
    bf16 *QB, *KVB, *UB, *VB, *SGA, *SGB; float* GT; float* out;
    __device__ __forceinline__ void operator()(const f32x4 (&acc)[2][2][4][2], const Unit& u, int wr, int wc, int fr, int fq) const {
        const int pn = u.pn; const int row0 = u.pm * 256 + wr * 64 + fr;
#pragma unroll
        for (int ai = 0; ai < 2; ++ai)
#pragma unroll
            for (int m = 0; m < 4; ++m) { const int row = row0 + ai * 128 + m * 16;
#pragma unroll
                for (int bj = 0; bj < 2; ++bj) { f32x4 v0 = acc[ai][bj][m][0], v1 = acc[ai][bj][m][1]; const int cl0 = bj * 128 + wc * 32 + 8 * fq;
                    if (pn < 2) { *(v4u*)(QB + (size_t)row * QW + pn * 256 + cl0) = pack8(v0 * QSCALE, v1 * QSCALE); }
                    else if (pn < 5) { const int ti = (pn - 2) * 2 + bj, c0 = wc * 32 + 8 * fq, b = row >> 13, t = row & 8191, gg = c0 >> 6, d0 = c0 & 63;
                        *(v4u*)(KVB + (size_t)ti * KVB_T + ((size_t)((b * 2 + gg) * TSEQ + t)) * 64 + d0) = pack8(v0, v1);
                        if (ti < 4) { float* o = out + O_PCK + (size_t)ti * MP * 128 + (size_t)row * 128 + c0; *(f32x4*)o = v0; *(f32x4*)(o + 4) = v1; }
                        else if (t >= TSEQ - 512) { float* o = out + (ti == 4 ? O_PWK : O_PWV) + ((size_t)(b * 512 + t - (TSEQ - 512))) * 128 + c0; *(f32x4*)o = v0; *(f32x4*)(o + 4) = v1; } }
                    else if (pn < 9) { f32x4 a, c;
#pragma unroll
                        for (int i = 0; i < 4; ++i) { a[i] = gelu_tanh_(v0[i]); c[i] = gelu_tanh_(v1[i]); }
                        bf16* dst = (pn < 7) ? (UB + (size_t)row * DB + (pn - 5) * 256 + cl0) : (VB + (size_t)row * DB + (pn - 7) * 256 + cl0); *(v4u*)dst = pack8(a, c); }
                    else if (pn < 17) { if (bj == 0) { const f32x4 w0 = acc[ai][1][m][0], w1 = acc[ai][1][m][1]; f32x4 ra, rc, gb0, gb1;
#pragma unroll
                            for (int i = 0; i < 4; ++i) { gb0[i] = sigmoidf_(w0[i]); gb1[i] = sigmoidf_(w1[i]); ra[i] = sigmoidf_(v0[i]) / gb0[i]; rc[i] = sigmoidf_(v1[i]) / gb1[i]; }
                            const size_t o = (size_t)row * DM + (pn - 9) * 128 + wc * 32 + 8 * fq; *(v4u*)(SGA + o) = pack8(ra, rc); *(v4u*)(SGB + o) = pack8(gb0, gb1); } }
                    else { if (bj == 0 && wc == 0 && fq < 3) { f32x4 a, c;
#pragma unroll
                            for (int i = 0; i < 4; ++i) { a[i] = sigmoidf_(v0[i]); c[i] = sigmoidf_(v1[i]); }
                            float* o = GT + (size_t)row * 24 + 8 * fq; *(f32x4*)o = a; *(f32x4*)(o + 4) = c; } }
                } }
    }
};
struct EpiMerge {
    static constexpr bool PERM = true, MIDK = true;
    const bf16 *SGA, *SGB; bf16* MB;
    __device__ __forceinline__ void mid(f32x4 (&acc)[2][2][4][2], const Unit& u, int wr, int wc, int fr, int fq) const {
        unsigned off0 = (unsigned)(u.pm * 256 + wr * 64 + fr) * DM + u.pn * 256 + wc * 32 + 8 * fq;
        asm volatile("" : "+v"(off0));
#pragma unroll
        for (int ai = 0; ai < 2; ++ai)
#pragma unroll
            for (int m = 0; m < 4; ++m) {
#pragma unroll
                for (int bj = 0; bj < 2; ++bj) { const v4u ga = *(const v4u*)(SGA + off0 + (unsigned)((ai * 128 + m * 16) * DM + bj * 128));
                    f32x4 r0, r1; r0[0] = bflo(ga.x); r0[1] = bfhi(ga.x); r0[2] = bflo(ga.y); r0[3] = bfhi(ga.y); r1[0] = bflo(ga.z); r1[1] = bfhi(ga.z); r1[2] = bflo(ga.w); r1[3] = bfhi(ga.w);
                    acc[ai][bj][m][0] *= r0; acc[ai][bj][m][1] *= r1;
                    asm volatile("" : "+v"(acc[ai][bj][m][0]), "+v"(acc[ai][bj][m][1]) :: "memory"); } }
    }
    __device__ __forceinline__ void operator()(const f32x4 (&acc)[2][2][4][2], const Unit& u, int wr, int wc, int fr, int fq) const {
        const unsigned off0 = (unsigned)(u.pm * 256 + wr * 64 + fr) * DM + u.pn * 256 + wc * 32 + 8 * fq;
#pragma unroll
        for (int ai = 0; ai < 2; ++ai)
#pragma unroll
            for (int m = 0; m < 4; ++m) {
#pragma unroll
                for (int bj = 0; bj < 2; ++bj) { const unsigned off = off0 + (unsigned)((ai * 128 + m * 16) * DM + bj * 128);
                    const v4u gb = *(const v4u*)(SGB + off);
                    f32x4 r0, r1; r0[0] = bflo(gb.x); r0[1] = bfhi(gb.x); r0[2] = bflo(gb.y); r0[3] = bfhi(gb.y); r1[0] = bflo(gb.z); r1[1] = bfhi(gb.z); r1[2] = bflo(gb.w); r1[3] = bfhi(gb.w);
                    *(v4u*)(MB + off) = pack8(acc[ai][bj][m][0] * r0, acc[ai][bj][m][1] * r1); }
                asm volatile("" ::: "memory"); }
    }
};

__device__ __forceinline__ int crow(int r, int hi) { return (r & 3) + 8 * (r >> 2) + 4 * hi; }
#define MFMA32(a, b, c) __builtin_amdgcn_mfma_f32_32x32x16_bf16((a), (b), (c), 0, 0, 0)
#define MFMA16(a, b, c) __builtin_amdgcn_mfma_f32_16x16x32_bf16((a), (b), (c), 0, 0, 0)
__device__ __forceinline__ f32x16 sk_partial(const bf16* A, int lda, const bf16* Bt, int ldb, int k0, int nk, int lane) {
    const int r32 = lane & 31, hi = lane >> 5; f32x16 acc = {};
    const bf16* ap = A + (size_t)r32 * lda + k0 + 8 * hi; const bf16* bp = Bt + (size_t)r32 * ldb + k0 + 8 * hi;
#pragma unroll 4
    for (int s = 0; s < nk; ++s) { const bf16x8 a = *(const bf16x8*)(ap + 16 * s), b = *(const bf16x8*)(bp + 16 * s); acc = MFMA32(a, b, acc); }
    return acc;
}
__device__ __forceinline__ void sk_store(LAS float* red, const f32x16& acc, int lane) {
    const int r32 = lane & 31, hi = lane >> 5;
#pragma unroll
    for (int x = 0; x < 16; ++x) red[crow(x, hi) * 32 + r32] = acc[x];
}
__device__ __forceinline__ float sk_sum(const LAS float* red, int e, int w0, int w1) { float s = 0.f; for (int w = w0; w < w1; ++w) s += red[w * 1024 + e]; return s; }

__device__ __forceinline__ void sk_ffn_in(Frame& F, const bf16* A, const bf16* Wt) {
    LAS float* red = (LAS float*)(F.lds + RING_OFF);
    for (int item = blockIdx.x; item < FF / 32; item += F.G) {
        const int c0 = 32 * item, j = c0 >> 7, w = c0 & 127;
        const f32x16 ag = sk_partial(A, DM, Wt + (size_t)(256 * j + w) * DM, DM, F.wave * 128, 8, F.lane);
        const f32x16 au = sk_partial(A, DM, Wt + (size_t)(256 * j + 128 + w) * DM, DM, F.wave * 128, 8, F.lane);
        sk_store(red + F.wave * 1024, ag, F.lane); sk_store(red + 8192 + F.wave * 1024, au, F.lane);
        __syncthreads();
        for (int e = F.tid; e < 1024; e += 512) { const float gv = sk_sum(red, e, 0, 8), uv = sk_sum(red + 8192, e, 0, 8);
            F.ACT()[(size_t)(MP + (e >> 5)) * FF + c0 + (e & 31)] = (bf16)f2bf(siluf_(gv) * uv); }
        __syncthreads();
    }
}
__device__ __forceinline__ void sk_resid(Frame& F, const bf16* A, int lda, const bf16* Wt, int ldb, int nk, const float* res, float a, float b) {
    LAS float* red = (LAS float*)(F.lds + RING_OFF);
    for (int item = blockIdx.x; item < DM / 32; item += F.G) {
        const int n0 = 32 * item;
        const f32x16 acc = sk_partial(A, lda, Wt + (size_t)n0 * ldb, ldb, F.wave * 16 * nk, nk, F.lane);
        sk_store(red + F.wave * 1024, acc, F.lane);
        __syncthreads();
        for (int e = F.tid; e < 1024; e += 512) { const int r = e >> 5, n = n0 + (e & 31); F.PRE()[(size_t)(MP + r) * DM + n] = a * res[(size_t)r * DM + n] + b * sk_sum(red, e, 0, 8); }
        __syncthreads();
    }
}
__device__ __forceinline__ void proj_elem(Frame& F, int srow, int n, float v) {
    const int pn = n >> 8, cl = n & 255; const size_t R = (size_t)MP + srow;
    if (pn < 2) F.QB()[R * QW + n] = (bf16)f2bf(v * QSCALE);
    else if (pn < 5) { const int ti = (pn - 2) * 2 + (cl >> 7), c = cl & 127;
        F.KVS()[(ti * 32 + srow) * 128 + c] = v;
        if (ti < 4) F.out[O_SCK + (size_t)ti * MS * 128 + srow * 128 + c] = v;
        else F.out[(ti == 4 ? O_SWK : O_SWV) + ((size_t)srow * 512 + 511) * 128 + c] = v; }
    else if (pn < 7) F.UB()[R * DB + (n - 1280)] = (bf16)f2bf(gelu_tanh_(v));
    else if (pn < 9) F.VB()[R * DB + (n - 1792)] = (bf16)f2bf(gelu_tanh_(v));
    else if (pn < 17) { const int c = (pn - 9) * 128 + (cl & 127); if (cl < 128) F.SGA()[R * DM + c] = (bf16)f2bf(sigmoidf_(v)); else F.SGB()[R * DM + c] = (bf16)f2bf(sigmoidf_(v)); }
    else if (n < 4352 + 24) F.GT()[R * 24 + (n - 4352)] = sigmoidf_(v);
}
__device__ __forceinline__ void sk_proj(Frame& F) {
    LAS float* red = (LAS float*)(F.lds + RING_OFF);
    const bf16* A = F.HB() + (size_t)MP * DM;
    for (int item = blockIdx.x; item < NPROJ / 32; item += F.G) {
        const int n0 = 32 * item;
        const f32x16 acc = sk_partial(A, DM, F.WIN() + (size_t)n0 * DM, DM, F.wave * 128, 8, F.lane);
        sk_store(red + F.wave * 1024, acc, F.lane);
        __syncthreads();
        for (int e = F.tid; e < 1024; e += 512) proj_elem(F, e >> 5, n0 + (e & 31), sk_sum(red, e, 0, 8));
        __syncthreads();
    }
}
__device__ __forceinline__ void sk_merge(Frame& F) {
    LAS float* red = (LAS float*)(F.lds + RING_OFF);
    const bf16* A = F.AZ() + (size_t)MP * DM;
    for (int item = blockIdx.x; item < DM / 32; item += F.G) {
        const int n0 = 32 * item;
        const f32x16 acc = sk_partial(A, DM, F.WAB() + (size_t)n0 * DM, DM, F.wave * 128, 8, F.lane);
        sk_store(red + F.wave * 1024, acc, F.lane);
        __syncthreads();
        for (int e = F.tid; e < 1024; e += 512) { const size_t off = (size_t)(MP + (e >> 5)) * DM + n0 + (e & 31);
            F.MB()[off] = (bf16)f2bf(bf2f(F.SGA()[off]) * sk_sum(red, e, 0, 4) + bf2f(F.SGB()[off]) * sk_sum(red, e, 4, 8)); }
        __syncthreads();
    }
}
__device__ __forceinline__ void tr_item(const float* W, int ldw, int srow0, int scol0, int nvalid, bf16* WT, int ldk, int drow0, int dk0, LAS float* scr, int lane) {
    const int n = lane & 31;
#pragma unroll 8
    for (int i = 0; i < 32; ++i) { const int kk = 2 * i + (lane >> 5); scr[kk * 33 + n] = (n < nvalid) ? W[(size_t)(srow0 + kk) * ldw + scol0 + n] : 0.f; }
    LDS_WAIT(); asm volatile("" ::: "memory");
    const int c = lane & 7;
#pragma unroll
    for (int j = 0; j < 4; ++j) { const int nn = (lane >> 3) + 8 * j; const LAS float* s = scr + (8 * c) * 33 + nn;
        v4u o; o.x = pk2(s[0 * 33], s[1 * 33]); o.y = pk2(s[2 * 33], s[3 * 33]); o.z = pk2(s[4 * 33], s[5 * 33]); o.w = pk2(s[6 * 33], s[7 * 33]);
        *(GAS v4u*)(WT + (size_t)(drow0 + nn) * ldk + dk0 + 8 * c) = o; }
    LDS_WAIT(); asm volatile("" ::: "memory");
}
__device__ __forceinline__ void p0_prologue(Frame& F) {
    LAS float* scr = (LAS float*)(F.lds + RING_OFF + F.wave * 16384);
    const int gw = F.vcu * NWAVES + F.wave, NGW = F.G * NWAVES, lane = F.lane;
    constexpr int I_FI = 16 * 176, I_FO = 44 * 32, I_WIN = 16 * 144, I_AB = 8 * 32, I_WO = 16 * 32, I_C1 = 16 * 4, I_W2 = 2 * 2;
    constexpr int NITEMS = 2 * I_FI + 2 * I_FO + I_WIN + 2 * I_AB + I_WO + 4 * I_C1 + 2 * I_W2;
    for (int it = gw; it < NITEMS; it += NGW) {
        int r = it;
        if (r < 2 * I_FI) { const float* W = r < I_FI ? F.f1wi() : F.f2wi(); bf16* WT = r < I_FI ? F.W1IN() : F.W2IN(); if (r >= I_FI) r -= I_FI;
            const int kb = r / 176, nb = r % 176, j = nb >> 3, w = nb & 7; const int sc = (w < 4) ? (128 * j + 32 * w) : (FF + 128 * j + 32 * (w - 4));
            tr_item(W, NFF2, 64 * kb, sc, 32, WT, DM, 32 * nb, 64 * kb, scr, lane); continue; }
        r -= 2 * I_FI;
        if (r < 2 * I_FO) { const float* W = r < I_FO ? F.f1wo() : F.f2wo(); bf16* WT = r < I_FO ? F.W1OUT() : F.W2OUT(); if (r >= I_FO) r -= I_FO;
            const int kb = r / 32, nb = r % 32; tr_item(W, DM, 64 * kb, 32 * nb, 32, WT, FF, 32 * nb, 64 * kb, scr, lane); continue; }
        r -= 2 * I_FO;
        if (r < I_WIN) { const int kb = r / 144, nb = r % 144, d0 = 32 * nb; int sc, nv = 32;
            if (d0 < 1280) sc = d0; else if (d0 < 1792) sc = 1304 + (d0 - 1280); else if (d0 < 2304) sc = 1816 + (d0 - 1792); else if (d0 < 4352) { const int jj = (d0 - 2304) >> 8, ww = (d0 - 2304) & 255; sc = (ww < 128) ? (2328 + 128 * jj + ww) : (3352 + 128 * jj + (ww - 128)); }
            else if (d0 == 4352) { sc = 1280; nv = 24; } else { sc = 0; nv = 0; }
            tr_item(F.win(), 4376, 64 * kb, sc, nv, F.WIN(), DM, d0, 64 * kb, scr, lane); continue; }
        r -= I_WIN;
        if (r < 2 * I_AB) { const float* W = r < I_AB ? F.wa() : F.wb(); const int dk = r < I_AB ? 0 : 512; if (r >= I_AB) r -= I_AB;
            const int kb = r / 32, nb = r % 32; tr_item(W, DM, 64 * kb, 32 * nb, 32, F.WAB(), DM, 32 * nb, dk + 64 * kb, scr, lane); continue; }
        r -= 2 * I_AB;
        if (r < I_WO) { const int kb = r / 32, nb = r % 32; tr_item(F.wout(), DM, 64 * kb, 32 * nb, 32, F.WOUT(), DM, 32 * nb, 64 * kb, scr, lane); continue; }
        r -= I_WO;
        if (r < 4 * I_C1) { const int q = r / I_C1, kv = q >> 1, part = q & 1; r -= q * I_C1; const int kb = r / 4, nb = r % 4;
            tr_item(kv ? F.w1v() : F.w1k(), 128, 1024 * part + 64 * kb, 32 * nb, 32, F.CW1() + (size_t)kv * 256 * DM, DM, 128 * part + 32 * nb, 64 * kb, scr, lane); continue; }
        r -= 4 * I_C1;
        { const int kv = r / I_W2; r -= kv * I_W2; const int kb = r / 2, nb = r % 2; tr_item(kv ? F.w2v() : F.w2k(), 64, 64 * kb, 32 * nb, 32, F.W2T() + kv * 64 * 128, 128, 32 * nb, 64 * kb, scr, lane); }
    }
    for (int m = gw; m < MP + MS; m += NGW) {
        const float* xr = (m < MP) ? F.x() + (size_t)m * DM : F.xs() + (size_t)(m - MP) * DM; bf16* o = F.XB() + (size_t)m * DM;
#pragma unroll
        for (int j = 0; j < 4; ++j) { const f32x4 v = *(const f32x4*)(xr + 4 * lane + 256 * j); v2u w; w.x = pk2(v[0], v[1]); w.y = pk2(v[2], v[3]); *(v2u*)(o + 4 * lane + 256 * j) = w; }
    }
    for (int rr = gw; rr < 2 * 65536; rr += NGW) {
        const int kv = rr >> 16, r = rr & 65535, bg = r >> 10, ns = r & 1023, b = bg >> 1, g = bg & 1;
        const int page = F.pt()[b * NPAGE + (ns >> 3)];
        const float* src = (kv ? F.ccv() : F.cck()) + ((size_t)page * 128 + (ns & 7) * 16) * 128 + g * 64;
        bf16* o = F.SC() + (size_t)rr * 1024;
#pragma unroll
        for (int j = 0; j < 4; ++j) { const int e = 4 * lane + 256 * j, s = e >> 6, d = e & 63; const f32x4 v = *(const f32x4*)(src + s * 128 + d); v2u w; w.x = pk2(v[0], v[1]); w.y = pk2(v[2], v[3]); *(v2u*)(o + e) = w; }
    }
    if (gw < 4) { const int kv = gw >> 1, n = (gw & 1) * 64 + lane; const float* pe = kv ? F.pev() : F.pek(); const float* w1 = kv ? F.w1v() : F.w1k(); float a = 0.f;
        for (int k = 0; k < 2048; ++k) a += pe[k] * w1[(size_t)k * 128 + n];
        F.CBIAS()[kv * 128 + n] = a; }
    for (int e = gw * 64 + lane; e < 2 * MS * 511 * 32; e += NGW * 64) {
        const int kv = e / (MS * 511 * 32), r = e % (MS * 511 * 32), b = r / (511 * 32), q = r % (511 * 32), w = q >> 5, c4 = q & 31;
        const f32x4 v = *(const f32x4*)((kv ? F.cwv() : F.cwk()) + ((size_t)(b * 512 + w + 1)) * 128 + 4 * c4);
        *(f32x4*)(F.out + (kv ? O_SWV : O_SWK) + ((size_t)(b * 512 + w)) * 128 + 4 * c4) = v;
    }
}
__device__ __forceinline__ void ln_phase(Frame& F, const float* src, const float* gam, const float* bet, float* of32_p, float* of32_s, bf16* ob16) {
    const int gw = F.vcu * NWAVES + F.wave, NGW = F.G * NWAVES, lane = F.lane;
    f32x4 gv[4], bv[4];
#pragma unroll
    for (int j = 0; j < 4; ++j) { gv[j] = *(const f32x4*)(gam + 4 * lane + 256 * j); bv[j] = *(const f32x4*)(bet + 4 * lane + 256 * j); }
    for (int m = gw; m < MP + MS; m += NGW) {
        const float* xr = src + (size_t)m * DM; f32x4 v[4]; float s = 0.f;
#pragma unroll
        for (int j = 0; j < 4; ++j) { v[j] = *(const f32x4*)(xr + 4 * lane + 256 * j); s += (v[j][0] + v[j][1]) + (v[j][2] + v[j][3]); }
        const float mean = wave_sum(s) * (1.f / DM); float s2 = 0.f;
#pragma unroll
        for (int j = 0; j < 4; ++j) { v[j] = v[j] - mean; s2 += (v[j][0] * v[j][0] + v[j][1] * v[j][1]) + (v[j][2] * v[j][2] + v[j][3] * v[j][3]); }
        const float rstd = 1.f / sqrtf(wave_sum(s2) * (1.f / DM) + LN_EPS);
        float* of = (m < MP) ? (of32_p ? of32_p + (size_t)m * DM : nullptr) : (of32_s ? of32_s + (size_t)(m - MP) * DM : nullptr);
#pragma unroll
        for (int j = 0; j < 4; ++j) { const f32x4 y = v[j] * rstd * gv[j] + bv[j];
            if (of) *(f32x4*)(of + 4 * lane + 256 * j) = y;
            if (ob16) { v2u w; w.x = pk2(y[0], y[1]); w.y = pk2(y[2], y[3]); *(v2u*)(ob16 + (size_t)m * DM + 4 * lane + 256 * j) = w; } }
    }
}
__device__ __forceinline__ void gmlp_chunk(Frame& F, int chunk) {
    LAS float* stats = (LAS float*)(F.lds + RING_OFF);
    LAS bf16* vnT = (LAS bf16*)(F.lds + RING_OFF + 1024);
    const int lane = F.lane, w = F.wave, row0 = chunk * 128;
    for (int tt = 0; tt < 16; ++tt) { const int t = 16 * w + tt; const v4u raw = *(const v4u*)(F.VB() + (size_t)(row0 + t) * DB + 8 * lane);
        float x[8] = {bflo(raw.x), bfhi(raw.x), bflo(raw.y), bfhi(raw.y), bflo(raw.z), bfhi(raw.z), bflo(raw.w), bfhi(raw.w)}; float s = 0.f;
#pragma unroll
        for (int i = 0; i < 8; ++i) s += x[i];
        const float mean = wave_sum(s) * (1.f / DB); float s2 = 0.f;
#pragma unroll
        for (int i = 0; i < 8; ++i) { const float d = x[i] - mean; s2 += d * d; }
        const float rstd = 1.f / sqrtf(wave_sum(s2) * (1.f / DB) + LN_EPS);
        if (lane == 0) { stats[2 * t] = mean; stats[2 * t + 1] = rstd; } }
    __syncthreads();
    for (int h = 0; h < 4; ++h) {
        for (int q = 0; q < 4; ++q) { const int idx = F.tid + 512 * q, t = idx >> 4, c8 = idx & 15; const v4u raw = *(const v4u*)(F.VB() + (size_t)(row0 + t) * DB + 128 * h + 8 * c8);
            const float mean = stats[2 * t], rstd = stats[2 * t + 1]; const float* gp = F.glg() + 128 * h + 8 * c8; const float* bp = F.glb() + 128 * h + 8 * c8;
            float x[8] = {bflo(raw.x), bfhi(raw.x), bflo(raw.y), bfhi(raw.y), bflo(raw.z), bfhi(raw.z), bflo(raw.w), bfhi(raw.w)};
#pragma unroll
            for (int i = 0; i < 8; ++i) vnT[(8 * c8 + i) * 136 + t] = (bf16)f2bf((x[i] - mean) * rstd * gp[i] + bp[i]); }
        __syncthreads();
        const int fr = lane & 15, quad = lane >> 4, s = 16 * w + fr, nks = (w >> 1) + 1;
        f32x4 acc[8];
#pragma unroll
        for (int ct = 0; ct < 8; ++ct) acc[ct] = (f32x4){0.f, 0.f, 0.f, 0.f};
        for (int ks = 0; ks < nks; ++ks) { const int t0 = 32 * ks + 8 * quad; const float* wp = F.spw() + ((size_t)(h * 128 + s)) * 128 + t0;
            const f32x4 w0 = *(const f32x4*)wp, w1 = *(const f32x4*)(wp + 4); float wv[8] = {w0[0], w0[1], w0[2], w0[3], w1[0], w1[1], w1[2], w1[3]};
#pragma unroll
            for (int i = 0; i < 8; ++i) if (t0 + i > s) wv[i] = 0.f;
            v4u aw; aw.x = pk2(wv[0], wv[1]); aw.y = pk2(wv[2], wv[3]); aw.z = pk2(wv[4], wv[5]); aw.w = pk2(wv[6], wv[7]); const bf16x8 a = __builtin_bit_cast(bf16x8, aw);
#pragma unroll
            for (int ct = 0; ct < 8; ++ct) { const bf16x8 b = *(const LAS bf16x8*)(vnT + (16 * ct + fr) * 136 + t0); acc[ct] = MFMA16(a, b, acc[ct]); } }
#pragma unroll
        for (int ct = 0; ct < 8; ++ct)
#pragma unroll
            for (int j = 0; j < 4; ++j) { const int so = 16 * w + 4 * quad + j, c = 128 * h + 16 * ct + fr; const size_t row = (size_t)row0 + so;
                const float z = bf2f(F.UB()[row * DB + c]) * (acc[ct][j] + F.spb()[h * 128 + so]); F.AZ()[row * DM + 512 + c] = (bf16)f2bf(z); }
        __syncthreads();
    }
}
__device__ __forceinline__ void gmlp_sample(Frame& F) {
    const int lane = F.lane;
    for (int rr = 0; rr < 4; ++rr) { const int s = 4 * F.wave + rr; const size_t row = (size_t)MP + s; const v4u raw = *(const v4u*)(F.VB() + row * DB + 8 * lane);
        float x[8] = {bflo(raw.x), bfhi(raw.x), bflo(raw.y), bfhi(raw.y), bflo(raw.z), bfhi(raw.z), bflo(raw.w), bfhi(raw.w)}; float sm = 0.f;
#pragma unroll
        for (int i = 0; i < 8; ++i) sm += x[i];
        const float mean = wave_sum(sm) * (1.f / DB); float s2 = 0.f;
#pragma unroll
        for (int i = 0; i < 8; ++i) { const float d = x[i] - mean; s2 += d * d; }
        const float rstd = 1.f / sqrtf(wave_sum(s2) * (1.f / DB) + LN_EPS);
        const int h = lane >> 4; const float w00 = F.spw()[(size_t)h * 128 * 128], b0 = F.spb()[h * 128];
#pragma unroll
        for (int i = 0; i < 8; ++i) { const int c = 8 * lane + i; const float vn = (x[i] - mean) * rstd * F.glg()[c] + F.glb()[c];
            F.out[O_SCH + (size_t)s * DB + c] = vn; F.AZ()[row * DM + 512 + c] = (bf16)f2bf(bf2f(F.UB()[row * DB + c]) * (w00 * vn + b0)); } }
}
__device__ __forceinline__ void cmp2_phase(Frame& F) {
    const int gw = F.vcu * NWAVES + F.wave, NGW = F.G * NWAVES, lane = F.lane, r32 = lane & 31, hi = lane >> 5;
    constexpr int PER = 8 * 16 + 64 * 32;
    for (int it = gw; it < 2 * PER; it += NGW) {
        const int kv = it / PER; int r = it % PER; int bg, i0, NS; const float* Hb; bf16* Ob;
        if (r < 128) { bg = r >> 4; i0 = (r & 15) * 32; NS = 512; Hb = F.HCP() + (size_t)kv * 4096 * 256; Ob = F.KCP() + (size_t)kv * 8 * 512 * 64; }
        else { r -= 128; bg = r >> 5; i0 = (r & 31) * 32; NS = 1024; Hb = F.HCS() + (size_t)kv * 65536 * 256; Ob = F.KCS() + (size_t)kv * 64 * 1024 * 64; }
        const int i = i0 + r32; const bool live = i < NS - 1;
        const float* h0 = Hb + ((size_t)bg * NS + i) * 256; const float* h1 = h0 + 256 + 128; const float* bias = F.CBIAS() + kv * 128; const bf16* w2 = F.W2T() + kv * 64 * 128;
        f32x16 a0 = {}, a1 = {};
#pragma unroll
        for (int ks = 0; ks < 8; ++ks) { const int k = 16 * ks + 8 * hi; float hv[8];
            if (live) { const f32x4 p0 = *(const f32x4*)(h0 + k), p1 = *(const f32x4*)(h0 + k + 4), q0 = *(const f32x4*)(h1 + k), q1 = *(const f32x4*)(h1 + k + 4), c0 = *(const f32x4*)(bias + k), c1 = *(const f32x4*)(bias + k + 4);
#pragma unroll
                for (int j = 0; j < 4; ++j) { hv[j] = gelu_tanh_(p0[j] + q0[j] + c0[j]); hv[4 + j] = gelu_tanh_(p1[j] + q1[j] + c1[j]); } }
            else {
#pragma unroll
                for (int j = 0; j < 8; ++j) hv[j] = 0.f; }
            v4u aw; aw.x = pk2(hv[0], hv[1]); aw.y = pk2(hv[2], hv[3]); aw.z = pk2(hv[4], hv[5]); aw.w = pk2(hv[6], hv[7]); const bf16x8 a = __builtin_bit_cast(bf16x8, aw);
            const bf16x8 b0 = *(const bf16x8*)(w2 + (size_t)r32 * 128 + k), b1 = *(const bf16x8*)(w2 + (size_t)(32 + r32) * 128 + k);
            a0 = MFMA32(a, b0, a0); a1 = MFMA32(a, b1, a1); }
#pragma unroll
        for (int x = 0; x < 16; ++x) { const size_t o = ((size_t)bg * NS + i0 + crow(x, hi)) * 64 + r32; Ob[o] = (bf16)f2bf(a0[x]); Ob[o + 32] = (bf16)f2bf(a1[x]); }
    }
}
__device__ __forceinline__ void ld16(const bf16* p, float (&x)[16]) {
#pragma unroll
    for (int j = 0; j < 2; ++j) { const v4u r = *(const v4u*)(p + 8 * j); x[8 * j] = bflo(r.x); x[8 * j + 1] = bfhi(r.x); x[8 * j + 2] = bflo(r.y); x[8 * j + 3] = bfhi(r.y); x[8 * j + 4] = bflo(r.z); x[8 * j + 5] = bfhi(r.z); x[8 * j + 6] = bflo(r.w); x[8 * j + 7] = bfhi(r.w); }
}
__device__ __forceinline__ void ld16(const float* p, float (&x)[16]) {
#pragma unroll
    for (int j = 0; j < 4; ++j) { const f32x4 r = *(const f32x4*)(p + 4 * j); x[4 * j] = r[0]; x[4 * j + 1] = r[1]; x[4 * j + 2] = r[2]; x[4 * j + 3] = r[3]; }
}
__device__ __forceinline__ float ld_el(const bf16* p, int d) { return bf2f(p[d]); }
__device__ __forceinline__ float ld_el(const float* p, int d) { return p[d]; }
template <class T> __device__ __forceinline__ void dot4_row(const LAS float* qs, const T* row, float (&s)[4]) {
    float a0 = 0.f, a1 = 0.f, a2 = 0.f, a3 = 0.f;
#pragma unroll
    for (int qd = 0; qd < 4; ++qd) { float x[16]; ld16(row + 16 * qd, x);
#pragma unroll
        for (int e = 0; e < 4; ++e) { const int d4 = 4 * qd + e; const f32x4 q0 = *(const LAS f32x4*)(qs + 4 * d4), q1 = *(const LAS f32x4*)(qs + 64 + 4 * d4), q2 = *(const LAS f32x4*)(qs + 128 + 4 * d4), q3 = *(const LAS f32x4*)(qs + 192 + 4 * d4);
            a0 += q0[0] * x[4 * e] + q0[1] * x[4 * e + 1] + q0[2] * x[4 * e + 2] + q0[3] * x[4 * e + 3];
            a1 += q1[0] * x[4 * e] + q1[1] * x[4 * e + 1] + q1[2] * x[4 * e + 2] + q1[3] * x[4 * e + 3];
            a2 += q2[0] * x[4 * e] + q2[1] * x[4 * e + 1] + q2[2] * x[4 * e + 2] + q2[3] * x[4 * e + 3];
            a3 += q3[0] * x[4 * e] + q3[1] * x[4 * e + 1] + q3[2] * x[4 * e + 2] + q3[3] * x[4 * e + 3]; }
        asm volatile("" : "+v"(a0), "+v"(a1), "+v"(a2), "+v"(a3) :: "memory"); }
    s[0] = a0; s[1] = a1; s[2] = a2; s[3] = a3;
}
template <bool SAMPLE, int BR, int KV> struct RowSrc;
template <int BR, int KV> struct RowSrc<false, BR, KV> { typedef bf16 T;
    static __device__ __forceinline__ const bf16* get(const Frame& F, int b, int g, int p) { return F.KVB() + (size_t)(2 * BR + KV) * KVB_T + ((size_t)((b * 2 + g) * TSEQ + p)) * 64; } };
template <int KV> struct RowSrc<true, 1, KV> { typedef float T;
    static __device__ __forceinline__ const float* get(const Frame& F, int b, int g, int p) {
        if (p >= PASTL) return F.KVS() + ((2 + KV) * 32 + b) * 128 + g * 64;
        return (KV ? F.csv() : F.csk()) + ((size_t)F.pt()[b * NPAGE + (p >> 7)] * 128 + (p & 127)) * 128 + g * 64; } };
template <int KV> struct RowSrc<true, 2, KV> { typedef float T;
    static __device__ __forceinline__ const float* get(const Frame& F, int b, int g, int p) {
        if (p >= PASTL) return F.KVS() + ((4 + KV) * 32 + b) * 128 + g * 64;
        return (KV ? F.cwv() : F.cwk()) + ((size_t)(b * 512 + (p - (PASTL - 512))) * 2 + g) * 64; } };

template <bool SAMPLE, int BR>
__device__ __forceinline__ void online_chunk(const Frame& F, int b, int g, int t, int p0, int lo, int hi_, const float (&slope)[4], const LAS float* qs, LAS float* pch, float (&m)[4], float (&l)[4], float (&o)[4], int lane) {
    const int p = p0 + lane; const bool v = (p >= lo) && (p <= hi_);
    const unsigned long long mask = __ballot(v);
    if (mask == 0ull) return;
    float s[4];
    if (v) { dot4_row(qs, RowSrc<SAMPLE, BR, 0>::get(F, b, g, p), s);
#pragma unroll
        for (int r = 0; r < 4; ++r) s[r] -= slope[r] * (float)(t - p); }
    else {
#pragma unroll
        for (int r = 0; r < 4; ++r) s[r] = -1e30f; }
#pragma unroll
    for (int r = 0; r < 4; ++r) { const float cm = wave_max(s[r]), mn = fmaxf(m[r], cm), sc_ = __expf(m[r] - mn), pr = v ? __expf(s[r] - mn) : 0.f;
        l[r] = l[r] * sc_ + wave_sum(pr); o[r] *= sc_; m[r] = mn; pch[r * 64 + lane] = pr; }
    LDS_WAIT(); asm volatile("" ::: "memory");
#pragma unroll 2
    for (int j = 0; j < 64; ++j) { if (!((mask >> j) & 1ull)) continue;
        const float vv = ld_el(RowSrc<SAMPLE, BR, 1>::get(F, b, g, p0 + j), lane);
#pragma unroll
        for (int r = 0; r < 4; ++r) o[r] += pch[r * 64 + j] * vv; }
    LDS_WAIT(); asm volatile("" ::: "memory");
}

template <bool SAMPLE>
__device__ __forceinline__ void naive_attn_item(const Frame& F, int b, int g, int t, size_t rowg, LAS float* wl, bf16* outb) {
    const int lane = F.lane;
    LAS float* qs = wl; LAS float* pch = wl + 256; LAS float* psum = wl + 512; LAS float* sc = wl + 1600; LAS int* sel = (LAS int*)(wl + 1920);
    constexpr int NSEL = SAMPLE ? 257 : 128, NCMAX = SAMPLE ? 1023 : 511, NS = SAMPLE ? 1024 : 512, NPS = 4 * NSEL + 8;
    const int bg = b * 2 + g;
    for (int e = lane; e < 256; e += 64) qs[e] = bf2f(F.QB()[rowg * QW + g * 256 + e]) * 0.6931471805599453f;
    for (int e = lane; e < NPS; e += 64) psum[e] = 0.f;
    float slope[4];
#pragma unroll
    for (int r = 0; r < 4; ++r) slope[r] = exp2f(-(float)(g * 4 + r + 1));
    LDS_WAIT(); asm volatile("" ::: "memory");
    int nvalid = t >= 31 ? (t - 31) / 16 + 1 : 0; if (nvalid > NCMAX) nvalid = NCMAX;
    const bf16* kc = (SAMPLE ? F.KCS() : F.KCP()) + (size_t)bg * NS * 64; const bf16* vc = kc + (SAMPLE ? (size_t)64 * 1024 * 64 : (size_t)8 * 512 * 64);
    float mc[4], lc[4], oc[4];
#pragma unroll
    for (int r = 0; r < 4; ++r) { mc[r] = -1e30f; lc[r] = 0.f; oc[r] = 0.f; }
#pragma unroll 1
    for (int i0 = 0; i0 < nvalid; i0 += 64) { const int i = i0 + lane; const bool v = i < nvalid; float s[4];
        if (v) { dot4_row(qs, kc + (size_t)i * 64, s);
#pragma unroll
            for (int r = 0; r < 4; ++r) s[r] -= slope[r] * (float)(t - (16 * i + 31)); }
        else {
#pragma unroll
            for (int r = 0; r < 4; ++r) s[r] = -1e30f; }
#pragma unroll
        for (int r = 0; r < 4; ++r) { const float cm = wave_max(s[r]), mn = fmaxf(mc[r], cm); lc[r] = lc[r] * __expf(mc[r] - mn) + wave_sum(v ? __expf(s[r] - mn) : 0.f); mc[r] = mn; } }
#pragma unroll 1
    for (int i0 = 0; i0 < nvalid; i0 += 64) { const int i = i0 + lane; const bool v = i < nvalid; float pr[4];
        if (v) { float s[4]; dot4_row(qs, kc + (size_t)i * 64, s);
#pragma unroll
            for (int r = 0; r < 4; ++r) pr[r] = __expf(s[r] - slope[r] * (float)(t - (16 * i + 31)) - mc[r]) / lc[r];
            psum[i] = (pr[0] + pr[1]) + (pr[2] + pr[3]); }
        else {
#pragma unroll
            for (int r = 0; r < 4; ++r) pr[r] = 0.f; }
#pragma unroll
        for (int r = 0; r < 4; ++r) pch[r * 64 + lane] = pr[r];
        LDS_WAIT(); asm volatile("" ::: "memory");
        const int nj = (nvalid - i0) < 64 ? (nvalid - i0) : 64;
#pragma unroll 2
        for (int j = 0; j < nj; ++j) { const float vv = bf2f(vc[(size_t)(i0 + j) * 64 + lane]);
#pragma unroll
            for (int r = 0; r < 4; ++r) oc[r] += pch[r * 64 + j] * vv; }
        LDS_WAIT(); asm volatile("" ::: "memory"); }
    const int cur = t >> 6;
    for (int j = lane; j < NSEL; j += 64) { float im = 0.f;
#pragma unroll
        for (int o = -1; o < 4; ++o) { const int i = 4 * j + o; if (i >= 0) im += psum[i]; }
        const bool valid = (j * 64) <= t, forced = (j == 0) || (j == cur) || (j == cur - 1);
        sc[j] = valid ? (forced ? 1e4f : im) : -1e30f; }
    LDS_WAIT(); asm volatile("" ::: "memory");
    int nsel_found = 0;
    for (int j0 = 0; j0 < NSEL; j0 += 64) { const int j = j0 + lane; bool s_ = false;
        if (j < NSEL) { const float sj = sc[j]; int c = 0;
#pragma unroll 4
            for (int i = 0; i < NSEL; ++i) { const float si = sc[i]; c += ((si > sj) || (si == sj && i < j)) ? 1 : 0; }
            s_ = c < 16; }
        const unsigned long long mk = __ballot(s_);
        if (s_) { const int pos = nsel_found + __popcll(mk & ((1ull << lane) - 1ull)); if (pos < 16) sel[pos] = j; }
        nsel_found += __popcll(mk); }
    LDS_WAIT(); asm volatile("" ::: "memory");
    float ms[4], ls[4], os[4], mw[4], lw[4], ow[4];
#pragma unroll
    for (int r = 0; r < 4; ++r) { ms[r] = -1e30f; ls[r] = 0.f; os[r] = 0.f; mw[r] = -1e30f; lw[r] = 0.f; ow[r] = 0.f; }
    const int nk = nsel_found < 16 ? nsel_found : 16;
#pragma unroll 1
    for (int k = 0; k < nk; ++k) { const int blk = __builtin_amdgcn_readfirstlane(sel[k]); online_chunk<SAMPLE, 1>(F, b, g, t, blk * 64, 0, t, slope, qs, pch, ms, ls, os, lane); }
#pragma unroll 1
    for (int c = 0; c < 8; ++c) online_chunk<SAMPLE, 2>(F, b, g, t, t - 511 + 64 * c, (t - 511) > 0 ? (t - 511) : 0, t, slope, qs, pch, mw, lw, ow, lane);
    const float* gt = F.GT() + rowg * 24 + g * 12;
#pragma unroll
    for (int r = 0; r < 4; ++r) { const float o = gt[3 * r] * oc[r] + gt[3 * r + 1] * (ls[r] > 0.f ? os[r] / ls[r] : 0.f) + gt[3 * r + 2] * (lw[r] > 0.f ? ow[r] / lw[r] : 0.f);
        outb[rowg * DM + g * 256 + r * 64 + lane] = (bf16)f2bf(o); }
}
__device__ __forceinline__ void attn_naive_phase(Frame& F, bf16* outb) {
    LAS float* wl = (LAS float*)(F.lds + RING_OFF + F.wave * 8192);
    const int gw = blockIdx.x * NWAVES + F.wave, NGW = F.G * NWAVES;
    for (int it = gw; it < MS * 2; it += NGW) { const int b = it >> 1, g = it & 1; naive_attn_item<true>(F, b, g, PASTL, (size_t)MP + b, wl, outb); }
    for (int it = gw; it < MP * 2; it += NGW) { const int bg = it >> 13, t = it & 8191, b = bg >> 1, g = bg & 1; naive_attn_item<false>(F, b, g, t, (size_t)b * TSEQ + t, wl, outb); }
}

constexpr int CW_STAT = 2048;
__device__ __forceinline__ void attn_check_phase(Frame& F) {
    const int gw = F.vcu * NWAVES + F.wave, NGW = F.G * NWAVES, lane = F.lane; float sd = 0.f, sb = 0.f, sds = 0.f, sbs = 0.f;
    for (int m = gw; m < MP + MS; m += NGW) { const v4u a = *(const v4u*)(F.AZ() + (size_t)m * DM + 8 * lane), c = *(const v4u*)(F.MB() + (size_t)m * DM + 8 * lane);
        float d = fmaxf(fmaxf(fabsf(bflo(a.x) - bflo(c.x)), fabsf(bfhi(a.x) - bfhi(c.x))), fmaxf(fabsf(bflo(a.y) - bflo(c.y)), fabsf(bfhi(a.y) - bfhi(c.y))));
        d = fmaxf(d, fmaxf(fmaxf(fabsf(bflo(a.z) - bflo(c.z)), fabsf(bfhi(a.z) - bfhi(c.z))), fmaxf(fabsf(bflo(a.w) - bflo(c.w)), fabsf(bfhi(a.w) - bfhi(c.w)))));
        if (!(d == d)) d = 1e3f;
#pragma unroll
        for (int o = 1; o < 32; o <<= 1) d = fmaxf(d, __shfl_xor(d, o));
        if ((lane & 31) == 0) { if (m < MP) { sd += d; sb += d > 0.03f ? 1.f : 0.f; } else { sds += d; sbs += d > 0.03f ? 1.f : 0.f; } } }
    sd = wave_sum(sd); sb = wave_sum(sb); sds = wave_sum(sds); sbs = wave_sum(sbs);
    if (lane == 0) { float* st = (float*)(F.ctl + CW_STAT); atomicAdd(st, sd); atomicAdd(st + 1, sb); atomicAdd(st + 2, sds); atomicAdd(st + 3, sbs); }
}
namespace fa {
constexpr int SLOT = 16384;
constexpr int L_IMP = 32768, L_SELW = 65536, L_WSF = 66560, L_OT = 68608, L_END = L_OT + 65536;
constexpr float L2E = 1.4426950408889634f, NEGBIG = -30000.f, THR = 8.f;
__device__ __forceinline__ float max3f(float a, float b, float c) { return fmaxf(fmaxf(a, b), c); }
__device__ __forceinline__ unsigned cvtpk(float lo, float hi) { typedef float f2 __attribute__((ext_vector_type(2))); typedef __bf16 b2 __attribute__((ext_vector_type(2))); f2 v = {lo, hi}; b2 b = __builtin_convertvector(v, b2); return __builtin_bit_cast(unsigned, b); }
__device__ __forceinline__ float swapmax(float m) { auto rr = __builtin_amdgcn_permlane32_swap(__float_as_uint(m), __float_as_uint(m), false, false); return fmaxf(__uint_as_float(rr[0]), __uint_as_float(rr[1])); }
__device__ __forceinline__ float swapadd(float m) { auto rr = __builtin_amdgcn_permlane32_swap(__float_as_uint(m), __float_as_uint(m), false, false); return __uint_as_float(rr[0]) + __uint_as_float(rr[1]); }
__device__ __forceinline__ float rowmax(const f32x16& p0, const f32x16& p1) {
    float a = max3f(p0[0], p0[1], p1[0]), b = max3f(p0[2], p0[3], p1[1]); a = max3f(a, p1[2], p1[3]);
#pragma unroll
    for (int r = 4; r < 16; r += 4) { a = max3f(a, p0[r], p0[r + 1]); b = max3f(b, p0[r + 2], p0[r + 3]); a = max3f(a, p1[r], p1[r + 1]); b = max3f(b, p1[r + 2], p1[r + 3]); }
    return swapmax(fmaxf(a, b));
}
__device__ __forceinline__ void dma_tile(LAS unsigned char* slot, const bf16* Kt, const bf16* Vt, int wid, int lane) {
    __builtin_amdgcn_global_load_lds((const unsigned*)(Kt + lane * 64 + wid * 8), (LAS unsigned*)(slot + wid * 1024), 16, 0, 0);
    if (Vt) __builtin_amdgcn_global_load_lds((const unsigned*)(Vt + (16 * (wid & 3) + (lane >> 2)) * 64 + (wid >> 2) * 32 + (lane & 3) * 8), (LAS unsigned*)(slot + 8192 + wid * 1024), 16, 0, 0);
}
__device__ __forceinline__ void qk_tile(f32x16& p0, f32x16& p1, const LAS unsigned char* Ks, const bf16x8 (&qr)[4], const bf16x8 ka0, const bf16x8 ka1, const bf16x8 qa, int r32, int hi) {
    const LAS unsigned char* kb = Ks + hi * 1024 + r32 * 16;
    const f32x16 z = {0.f, 0.f, 0.f, 0.f, 0.f, 0.f, 0.f, 0.f, 0.f, 0.f, 0.f, 0.f, 0.f, 0.f, 0.f, 0.f};
    p0 = MFMA32(ka0, qa, z); p1 = MFMA32(ka1, qa, z);
#pragma unroll
    for (int d0 = 0; d0 < 4; ++d0) { const bf16x8 b0 = *(const LAS bf16x8*)(kb + d0 * 2048), b1 = *(const LAS bf16x8*)(kb + d0 * 2048 + 512); p0 = MFMA32(b0, qr[d0], p0); p1 = MFMA32(b1, qr[d0], p1); }
}
typedef short s16x4 __attribute__((ext_vector_type(4)));
__device__ __forceinline__ void pv_tile(f32x16 (&o)[2], int vb, const bf16x8 pa0, const bf16x8 pa1, const bf16x8 pa2, const bf16x8 pa3) {
#pragma unroll
    for (int d0 = 0; d0 < 2; ++d0) { s16x4 lo[4], hi_[4];
#pragma unroll
        for (int ks = 0; ks < 4; ++ks) {
            asm volatile("ds_read_b64_tr_b16 %0,%1 offset:%c2" : "=&v"(lo[ks]) : "v"(vb), "i"(d0 * 4096 + ks * 1024) : "memory");
            asm volatile("ds_read_b64_tr_b16 %0,%1 offset:%c2" : "=&v"(hi_[ks]) : "v"(vb), "i"(d0 * 4096 + ks * 1024 + 512) : "memory"); }
        asm volatile("s_waitcnt lgkmcnt(0)" ::: "memory"); __builtin_amdgcn_sched_barrier(0);
#define FA_PK(k) (bf16x8){lo[k][0], lo[k][1], lo[k][2], lo[k][3], hi_[k][0], hi_[k][1], hi_[k][2], hi_[k][3]}
        o[d0] = MFMA32(pa0, FA_PK(0), o[d0]); o[d0] = MFMA32(pa1, FA_PK(1), o[d0]); o[d0] = MFMA32(pa2, FA_PK(2), o[d0]); o[d0] = MFMA32(pa3, FA_PK(3), o[d0]);
#undef FA_PK
    }
}
__device__ __forceinline__ unsigned aug_c(float c, int hi) { const unsigned h = cvtpk(c, 0.f) & 0xffffu; const float chf = __uint_as_float(h << 16); const unsigned w = cvtpk(c, c - chf); return hi ? 0u : w; }

struct St { float mhat, l; };
__device__ __forceinline__ void st_init(St& s) { s.mhat = 0.f; s.l = 0.f; }
__device__ __forceinline__ bool sm_shift(St& s, f32x16& p0, f32x16& p1, LAS float* wsf, int r32, int hi) {
    const float rm = rowmax(p0, p1);
    if (__builtin_expect(__any(rm > THR), 0)) { const float dl = fmaxf(rm, 0.f); s.mhat += dl;
#pragma unroll
        for (int r = 0; r < 16; ++r) { p0[r] -= dl; p1[r] -= dl; }
        const float f = __builtin_amdgcn_exp2f(-dl); s.l *= f; if (hi == 0) wsf[r32] = f; return true; }
    return false;
}
__device__ __forceinline__ void sm_exp_sum(St& s, f32x16& p0, f32x16& p1) { float a = 0.f, b = 0.f;
#pragma unroll
    for (int r = 0; r < 16; ++r) { p0[r] = __builtin_amdgcn_exp2f(p0[r]); p1[r] = __builtin_amdgcn_exp2f(p1[r]); a += p0[r]; b += p1[r]; }
    s.l += a + b; }
#define FA_PACK4(P, B) __builtin_bit_cast(bf16x8, (v4u){cvtpk(P[B], P[B + 1]), cvtpk(P[B + 2], P[B + 3]), cvtpk(P[B + 4], P[B + 5]), cvtpk(P[B + 6], P[B + 7])})
__device__ __forceinline__ void o_rescale(f32x16 (&o)[2], const LAS float* wsf, int hi) {
    asm volatile("s_waitcnt lgkmcnt(0)" ::: "memory");
#pragma unroll
    for (int r = 0; r < 16; ++r) { const float f = wsf[crow(r, hi)]; o[0][r] *= f; o[1][r] *= f; }
}
template <bool GT> __device__ __forceinline__ void emask(f32x16& p0, f32x16& p1, int thr, int hi) {
#pragma unroll
    for (int r = 0; r < 16; ++r) { const int kv = crow(r, hi); const bool k0 = GT ? (kv > thr) : (kv <= thr), k1 = GT ? (kv + 32 > thr) : (kv + 32 <= thr); if (!k0) p0[r] = NEGBIG; if (!k1) p1[r] = NEGBIG; }
}

__device__ __forceinline__ void attn_unit(Frame& F, int bg, int qt) {
    LAS unsigned char* lds = F.lds + RING_OFF;
    const int lane = F.lane, wid = F.wave, r32 = lane & 31, hi = lane >> 5, b = bg >> 1, g = bg & 1;
    const int t0 = qt * 64, lq = 8 * wid + (r32 >> 2), head = r32 & 3, t = t0 + lq; const size_t row = (size_t)b * TSEQ + t;
    LAS float* IMP = (LAS float*)(lds + L_IMP); LAS unsigned* SELW = (LAS unsigned*)(lds + L_SELW); LAS float* wsf = (LAS float*)(lds + L_WSF) + wid * 64;
    const int vb = (int)(unsigned)(uintptr_t)(lds + 8192) + ((lane >> 4) & 1) * 32 + (lane & 3) * 8 + (4 * hi + ((lane & 15) >> 2)) * 64;
    bf16x8 qr[4];
    { const bf16* qp = F.QB() + row * QW + g * 256 + head * 64 + 8 * hi;
#pragma unroll
      for (int d0 = 0; d0 < 4; ++d0) qr[d0] = *(const bf16x8*)(qp + 16 * d0); }
    const float sl2 = exp2f(-(float)(g * 4 + head + 1)) * L2E;
    const unsigned slw = hi ? 0u : aug_c(sl2, 0), slw16 = hi ? 0u : aug_c(16.f * sl2, 0);
    const unsigned one2 = hi ? 0u : 0x3f803f80u;
    const bf16x8 ka0 = __builtin_bit_cast(bf16x8, (v4u){one2, hi ? 0u : cvtpk((float)r32, (float)r32), 0u, 0u}), ka1 = __builtin_bit_cast(bf16x8, (v4u){one2, hi ? 0u : cvtpk((float)(r32 + 32), (float)(r32 + 32)), 0u, 0u});
    LAS float* OT = (LAS float*)(lds + L_OT) + wid * 2048 + lane;
    const float* gt = F.GT() + row * 24 + (g * 4 + head) * 3;
    const bf16* KC = F.KCP() + (size_t)bg * 512 * 64; const bf16* VC = KC + (size_t)8 * 512 * 64;
    const bf16* KS = F.KVB() + 2 * KVB_T + (size_t)bg * TSEQ * 64; const bf16* VS = KS + KVB_T; const bf16* KW = KS + 2 * KVB_T; const bf16* VW = KS + 3 * KVB_T;
    for (int e = lane; e < 8 * 128; e += 64) IMP[(8 * wid) * 128 + e] = 0.f;
    const int nv = t >= 31 ? ((t - 31) >> 4) + 1 : 0;
    const int nvmax = ((t0 + 63 - 31) >> 4) + 1, nvmin = t0 >= 31 ? ((t0 - 31) >> 4) + 1 : 0, ntc = (nvmax + 63) >> 6;
    St sc; st_init(sc);
    f32x16 p0, p1;
    __syncthreads();
    dma_tile(lds, KC, nullptr, wid, lane);
    for (int ct = 0; ct < ntc; ++ct) {
        __syncthreads();
        if (ct + 1 < ntc) dma_tile(lds + ((ct + 1) & 1) * SLOT, KC + (size_t)(ct + 1) * 4096, nullptr, wid, lane);
        const bf16x8 qa = __builtin_bit_cast(bf16x8, (v4u){aug_c(sl2 * (float)(1024 * ct + 31 - t) - sc.mhat, hi), slw16, 0u, 0u});
        qk_tile(p0, p1, lds + (ct & 1) * SLOT, qr, ka0, ka1, qa, r32, hi);
        if (64 * (ct + 1) > nvmin) emask<false>(p0, p1, nv - 64 * ct - 1, hi);
        (void)sm_shift(sc, p0, p1, wsf, r32, hi);
        sm_exp_sum(sc, p0, p1);
    }
    const float lc = swapadd(sc.l), invl = lc > 0.f ? 1.0f / lc : 0.f;
    f32x16 o[2];
#pragma unroll
    for (int r = 0; r < 16; ++r) { o[0][r] = 0.f; o[1][r] = 0.f; }
    __syncthreads();
    dma_tile(lds, KC, VC, wid, lane);
    for (int ct = 0; ct < ntc; ++ct) {
        __syncthreads();
        if (ct + 1 < ntc) dma_tile(lds + ((ct + 1) & 1) * SLOT, KC + (size_t)(ct + 1) * 4096, VC + (size_t)(ct + 1) * 4096, wid, lane);
        const bf16x8 qa = __builtin_bit_cast(bf16x8, (v4u){aug_c(sl2 * (float)(1024 * ct + 31 - t) - sc.mhat, hi), slw16, 0u, 0u});
        qk_tile(p0, p1, lds + (ct & 1) * SLOT, qr, ka0, ka1, qa, r32, hi);
        if (64 * (ct + 1) > nvmin) emask<false>(p0, p1, nv - 64 * ct - 1, hi);
#pragma unroll
        for (int r = 0; r < 16; ++r) { p0[r] = __builtin_amdgcn_exp2f(p0[r]) * invl; p1[r] = __builtin_amdgcn_exp2f(p1[r]) * invl; }
#pragma unroll
        for (int rr = 0; rr < 4; ++rr) {
            float s0 = (p0[4 * rr] + p0[4 * rr + 1]) + (p0[4 * rr + 2] + p0[4 * rr + 3]), e0 = p0[4 * rr + 3], s1 = (p1[4 * rr] + p1[4 * rr + 1]) + (p1[4 * rr + 2] + p1[4 * rr + 3]), e1 = p1[4 * rr + 3];
            s0 += __shfl_xor(s0, 1); e0 += __shfl_xor(e0, 1); s1 += __shfl_xor(s1, 1); e1 += __shfl_xor(e1, 1);
            s0 += __shfl_xor(s0, 2); e0 += __shfl_xor(e0, 2); s1 += __shfl_xor(s1, 2); e1 += __shfl_xor(e1, 2);
            if (head == 0) { const int bin = 16 * ct + 2 * rr + hi; LAS float* ip = IMP + lq * 128 + bin;
                (void)__hip_atomic_fetch_add(ip, s0, __ATOMIC_RELAXED, __HIP_MEMORY_SCOPE_WORKGROUP); (void)__hip_atomic_fetch_add(ip + 8, s1, __ATOMIC_RELAXED, __HIP_MEMORY_SCOPE_WORKGROUP); (void)__hip_atomic_fetch_add(ip + 1, e0, __ATOMIC_RELAXED, __HIP_MEMORY_SCOPE_WORKGROUP); if (bin + 9 < 128) (void)__hip_atomic_fetch_add(ip + 9, e1, __ATOMIC_RELAXED, __HIP_MEMORY_SCOPE_WORKGROUP); } }
        pv_tile(o, vb + (ct & 1) * SLOT, FA_PACK4(p0, 0), FA_PACK4(p0, 8), FA_PACK4(p1, 0), FA_PACK4(p1, 8));
    }
    if (hi == 0) wsf[r32] = gt[0];
    o_rescale(o, wsf, hi);
#pragma unroll
    for (int r = 0; r < 16; ++r) { OT[(2 * r) * 64] = o[0][r]; OT[(2 * r + 1) * 64] = o[1][r]; }
    asm volatile("s_waitcnt lgkmcnt(0)" ::: "memory");
    { const int ql = lane >> 3, e = lane & 7, tq = t0 + 8 * wid + ql, cur = tq >> 6; const LAS float* ip = IMP + (8 * wid + ql) * 128 + 16 * e;
      unsigned key[16];
#pragma unroll
      for (int c4 = 0; c4 < 4; ++c4) { const f32x4 v = *(const LAS f32x4*)(ip + 4 * c4);
#pragma unroll
          for (int i = 0; i < 4; ++i) { const int j = 16 * e + 4 * c4 + i; const bool valid = (j * 64) <= tq, forced = (j == 0) || (j == cur) || (j == cur - 1);
              key[4 * c4 + i] = valid ? ((__float_as_uint(forced ? 1e4f : v[i]) & 0xffffff80u) | (unsigned)(127 - j)) : 0u; } }
#pragma unroll 1
      for (int it = 0; it < 16; ++it) { unsigned m = key[0];
#pragma unroll
          for (int c = 1; c < 16; ++c) m = m > key[c] ? m : key[c];
          { unsigned o1 = (unsigned)__shfl_xor((int)m, 1); m = m > o1 ? m : o1; o1 = (unsigned)__shfl_xor((int)m, 2); m = m > o1 ? m : o1; o1 = (unsigned)__shfl_xor((int)m, 4); m = m > o1 ? m : o1; }
#pragma unroll
          for (int c = 0; c < 16; ++c) key[c] = (key[c] == m) ? 0u : key[c]; }
      unsigned selbits = 0u;
#pragma unroll
      for (int c = 15; c >= 0; --c) selbits = (selbits << 1) | (key[c] == 0u ? 1u : 0u);
      const unsigned up = (unsigned)__shfl_down((int)selbits, 1);
      if ((e & 1) == 0) SELW[(8 * wid + ql) * 4 + (e >> 1)] = selbits | (up << 16); }
    asm volatile("s_waitcnt lgkmcnt(0)" ::: "memory");
    unsigned selm[4], wor[4];
#pragma unroll
    for (int k = 0; k < 4; ++k) selm[k] = SELW[lq * 4 + k];
#pragma unroll
    for (int k = 0; k < 4; ++k) { unsigned a = 0u;
#pragma unroll
        for (int q = 0; q < 8; ++q) a |= (unsigned)__builtin_amdgcn_readlane((int)selm[k], 4 * q);
        wor[k] = a; }
    St ss; st_init(ss);
#pragma unroll
    for (int r = 0; r < 16; ++r) { o[0][r] = 0.f; o[1][r] = 0.f; }
    __syncthreads();
    dma_tile(lds, KS, VS, wid, lane);
    for (int j = 0; j <= qt; ++j) {
        __syncthreads();
        if (j + 1 <= qt) dma_tile(lds + ((j + 1) & 1) * SLOT, KS + (size_t)(j + 1) * 4096, VS + (size_t)(j + 1) * 4096, wid, lane);
        const unsigned wbit = (j < 32 ? wor[0] >> j : j < 64 ? wor[1] >> (j - 32) : j < 96 ? wor[2] >> (j - 64) : wor[3] >> (j - 96)) & 1u;
        if (wbit) {
            const unsigned sw = j < 32 ? selm[0] >> j : j < 64 ? selm[1] >> (j - 32) : j < 96 ? selm[2] >> (j - 64) : selm[3] >> (j - 96);
            const float c = (sw & 1u) ? sl2 * (float)(64 * j - t) - ss.mhat : NEGBIG;
            const bf16x8 qa = __builtin_bit_cast(bf16x8, (v4u){aug_c(c, hi), slw, 0u, 0u});
            qk_tile(p0, p1, lds + (j & 1) * SLOT, qr, ka0, ka1, qa, r32, hi);
            if (j == qt) emask<false>(p0, p1, lq, hi);
            if (sm_shift(ss, p0, p1, wsf, r32, hi)) o_rescale(o, wsf, hi);
            sm_exp_sum(ss, p0, p1);
            pv_tile(o, vb + (j & 1) * SLOT, FA_PACK4(p0, 0), FA_PACK4(p0, 8), FA_PACK4(p1, 0), FA_PACK4(p1, 8));
        }
    }
    { const float ls = swapadd(ss.l); if (hi == 0) wsf[r32] = ls > 0.f ? gt[1] / ls : 0.f; }
    o_rescale(o, wsf, hi);
#pragma unroll
    for (int r = 0; r < 16; ++r) { OT[(2 * r) * 64] += o[0][r]; OT[(2 * r + 1) * 64] += o[1][r]; }
    St sw_; st_init(sw_);
#pragma unroll
    for (int r = 0; r < 16; ++r) { o[0][r] = 0.f; o[1][r] = 0.f; }
    const int w0 = qt >= 8 ? qt - 8 : 0;
    __syncthreads();
    dma_tile(lds, KW + (size_t)w0 * 4096, VW + (size_t)w0 * 4096, wid, lane);
    for (int wt = w0; wt <= qt; ++wt) { const int k = wt - w0;
        __syncthreads();
        if (wt + 1 <= qt) dma_tile(lds + ((k + 1) & 1) * SLOT, KW + (size_t)(wt + 1) * 4096, VW + (size_t)(wt + 1) * 4096, wid, lane);
        const bf16x8 qa = __builtin_bit_cast(bf16x8, (v4u){aug_c(sl2 * (float)(64 * wt - t) - sw_.mhat, hi), slw, 0u, 0u});
        qk_tile(p0, p1, lds + (k & 1) * SLOT, qr, ka0, ka1, qa, r32, hi);
        if (wt == qt) emask<false>(p0, p1, lq, hi);
        if (wt == qt - 8) emask<true>(p0, p1, lq, hi);
        if (sm_shift(sw_, p0, p1, wsf, r32, hi)) o_rescale(o, wsf, hi);
        sm_exp_sum(sw_, p0, p1);
        pv_tile(o, vb + (k & 1) * SLOT, FA_PACK4(p0, 0), FA_PACK4(p0, 8), FA_PACK4(p1, 0), FA_PACK4(p1, 8));
    }
    { const float lw = swapadd(sw_.l); if (hi == 0) wsf[r32] = lw > 0.f ? gt[2] / lw : 0.f; }
    o_rescale(o, wsf, hi);
    bf16* oz = F.AZ() + ((size_t)b * TSEQ + t0 + 8 * wid) * DM + g * 256;
#pragma unroll
    for (int r = 0; r < 16; ++r) { const int col = crow(r, hi); bf16* op = oz + (size_t)(col >> 2) * DM + (col & 3) * 64 + r32;
        op[0] = (bf16)f2bf(OT[(2 * r) * 64] + o[0][r]); op[32] = (bf16)f2bf(OT[(2 * r + 1) * 64] + o[1][r]); }
}
}
__device__ __forceinline__ void sample_attn_wg(Frame& F, int b, int g) {
    LAS float* base = (LAS float*)(F.lds + RING_OFF);
    LAS float* qs = base; LAS float* psum = base + 256; LAS float* scb = base + 1344; LAS int* sel = (LAS int*)(base + 1664); LAS float* stA = base + 1696; LAS float* part = base + 1792;
    LAS float* pch = base + 6016 + F.wave * 256; LAS float* ocp = base + 8064; LAS int* nselp = (LAS int*)(base + 10112);
    const int lane = F.lane, w = F.wave, t = PASTL, bg = b * 2 + g; const size_t rowg = (size_t)MP + b;
    constexpr int NSEL = 257, NV = 1023, NPS = 4 * NSEL + 8;
    __syncthreads();
    for (int e = F.tid; e < 256; e += 512) qs[e] = bf2f(F.QB()[rowg * QW + g * 256 + e]) * 0.6931471805599453f;
    for (int e = F.tid; e < NPS; e += 512) psum[e] = 0.f;
    float slope[4];
#pragma unroll
    for (int r = 0; r < 4; ++r) slope[r] = exp2f(-(float)(g * 4 + r + 1));
    __syncthreads();
    const bf16* kc = F.KCS() + (size_t)bg * 1024 * 64; const bf16* vc = kc + (size_t)64 * 1024 * 64;
    float mc[4], lc[4];
#pragma unroll
    for (int r = 0; r < 4; ++r) { mc[r] = -1e30f; lc[r] = 0.f; }
#pragma unroll 1
    for (int i0 = 64 * w; i0 < NV; i0 += 512) { const int i = i0 + lane; const bool v = i < NV; float s[4];
        if (v) { dot4_row(qs, kc + (size_t)i * 64, s);
#pragma unroll
            for (int r = 0; r < 4; ++r) s[r] -= slope[r] * (float)(t - (16 * i + 31)); }
        else {
#pragma unroll
            for (int r = 0; r < 4; ++r) s[r] = -1e30f; }
#pragma unroll
        for (int r = 0; r < 4; ++r) { const float cm = wave_max(s[r]), mn = fmaxf(mc[r], cm); lc[r] = lc[r] * __expf(mc[r] - mn) + wave_sum(v ? __expf(s[r] - mn) : 0.f); mc[r] = mn; } }
    if (lane == 0) {
#pragma unroll
        for (int r = 0; r < 4; ++r) { stA[w * 8 + r] = mc[r]; stA[w * 8 + 4 + r] = lc[r]; } }
    __syncthreads();
    float M[4], L[4];
#pragma unroll
    for (int r = 0; r < 4; ++r) { float m = -1e30f; for (int ww = 0; ww < 8; ++ww) m = fmaxf(m, stA[ww * 8 + r]); float l = 0.f; for (int ww = 0; ww < 8; ++ww) l += stA[ww * 8 + 4 + r] * __expf(stA[ww * 8 + r] - m); M[r] = m; L[r] = l; }
    float oc[4] = {0.f, 0.f, 0.f, 0.f};
#pragma unroll 1
    for (int i0 = 64 * w; i0 < NV; i0 += 512) { const int i = i0 + lane; const bool v = i < NV; float pr[4];
        if (v) { float s[4]; dot4_row(qs, kc + (size_t)i * 64, s);
#pragma unroll
            for (int r = 0; r < 4; ++r) pr[r] = __expf(s[r] - slope[r] * (float)(t - (16 * i + 31)) - M[r]) / L[r];
            psum[i] = (pr[0] + pr[1]) + (pr[2] + pr[3]); }
        else {
#pragma unroll
            for (int r = 0; r < 4; ++r) pr[r] = 0.f; }
#pragma unroll
        for (int r = 0; r < 4; ++r) pch[r * 64 + lane] = pr[r];
        LDS_WAIT(); asm volatile("" ::: "memory");
        const int nj = (NV - i0) < 64 ? (NV - i0) : 64;
#pragma unroll 2
        for (int j = 0; j < nj; ++j) { const float vv = bf2f(vc[(size_t)(i0 + j) * 64 + lane]);
#pragma unroll
            for (int r = 0; r < 4; ++r) oc[r] += pch[r * 64 + j] * vv; }
        LDS_WAIT(); asm volatile("" ::: "memory"); }
#pragma unroll
    for (int r = 0; r < 4; ++r) ocp[(w * 4 + r) * 64 + lane] = oc[r];
    __syncthreads();
    if (w == 0) { const int cur = t >> 6;
        for (int j = lane; j < NSEL; j += 64) { float im = 0.f;
#pragma unroll
            for (int o = -1; o < 4; ++o) { const int i = 4 * j + o; if (i >= 0) im += psum[i]; }
            const bool valid = (j * 64) <= t, forced = (j == 0) || (j == cur) || (j == cur - 1);
            scb[j] = valid ? (forced ? 1e4f : im) : -1e30f; }
        LDS_WAIT(); asm volatile("" ::: "memory");
        int nf = 0;
        for (int j0 = 0; j0 < NSEL; j0 += 64) { const int j = j0 + lane; bool s_ = false;
            if (j < NSEL) { const float sj = scb[j]; int c = 0;
#pragma unroll 4
                for (int i = 0; i < NSEL; ++i) { const float si = scb[i]; c += ((si > sj) || (si == sj && i < j)) ? 1 : 0; }
                s_ = c < 16; }
            const unsigned long long mk = __ballot(s_);
            if (s_) { const int pos = nf + __popcll(mk & ((1ull << lane) - 1ull)); if (pos < 16) sel[pos] = j; }
            nf += __popcll(mk); }
        if (lane == 0) nselp[0] = nf < 16 ? nf : 16; }
    __syncthreads();
    float ms[4], ls[4], os[4], mw[4], lw[4], ow[4];
#pragma unroll
    for (int r = 0; r < 4; ++r) { ms[r] = -1e30f; ls[r] = 0.f; os[r] = 0.f; mw[r] = -1e30f; lw[r] = 0.f; ow[r] = 0.f; }
    const int nk = nselp[0];
#pragma unroll 1
    for (int k = w; k < nk; k += 8) { const int blk = __builtin_amdgcn_readfirstlane(sel[k]); online_chunk<true, 1>(F, b, g, t, blk * 64, 0, t, slope, qs, pch, ms, ls, os, lane); }
    online_chunk<true, 2>(F, b, g, t, t - 511 + 64 * w, t - 511, t, slope, qs, pch, mw, lw, ow, lane);
#pragma unroll
    for (int r = 0; r < 4; ++r) { LAS float* p0 = part + ((w * 2 + 0) * 4 + r) * 66; LAS float* p1 = part + ((w * 2 + 1) * 4 + r) * 66;
        if (lane == 0) { p0[0] = ms[r]; p0[1] = ls[r]; p1[0] = mw[r]; p1[1] = lw[r]; }
        p0[2 + lane] = os[r]; p1[2 + lane] = ow[r]; }
    __syncthreads();
    if (w < 4) { const int r = w; float o_c = 0.f;
        for (int ww = 0; ww < 8; ++ww) o_c += ocp[(ww * 4 + r) * 64 + lane];
        float res[2];
#pragma unroll
        for (int br = 0; br < 2; ++br) { float m = -1e30f; for (int ww = 0; ww < 8; ++ww) m = fmaxf(m, part[((ww * 2 + br) * 4 + r) * 66]);
            float l = 0.f, o = 0.f; for (int ww = 0; ww < 8; ++ww) { const LAS float* p = part + ((ww * 2 + br) * 4 + r) * 66; const float f = __expf(p[0] - m); l += p[1] * f; o += p[2 + lane] * f; }
            res[br] = l > 0.f ? o / l : 0.f; }
        const float* gt = F.GT() + rowg * 24 + (g * 4 + r) * 3;
        F.AZ()[rowg * DM + g * 256 + r * 64 + lane] = (bf16)f2bf(gt[0] * o_c + gt[1] * res[0] + gt[2] * res[1]); }
    __syncthreads();
}
__device__ __forceinline__ void attn_fast_phase(Frame& F) {
    if (F.G == 256) {
        const int v = F.vcu;
        if (v >= 192) sample_attn_wg(F, (v - 192) >> 1, (v - 192) & 1);
        const int bg = v >> 5, s = v & 31;
#pragma unroll 1
        for (int i = 0; i < 4; ++i) { const int qt = (i == 0) ? 127 - s : (i == 1) ? 64 + s : (i == 2) ? 63 - s : s; fa::attn_unit(F, bg, qt); }
    } else {
    }
}
#ifndef ATTN_NAIVE
#define ATTN_NAIVE 0
#endif
#ifndef ATTN_CHECK
#define ATTN_CHECK 0
#endif
#ifndef CHECK_GAIN
#define CHECK_GAIN 1000.f
#endif
#ifndef MK_SPLIT
#define MK_SPLIT 0
#endif
constexpr int N_PHASES = 15;
struct Args { const void* in[33]; float* out; unsigned char* ws; int ph_lo, ph_hi; };
__global__ void __launch_bounds__(NWAVES * 64, 2) nsa_fwd(Args args) {
    extern __shared__ __attribute__((aligned(16))) unsigned char lds[];
    Frame F;
    F.lds = (LAS unsigned char*)lds;
    F.MISC = (volatile LAS unsigned*)(F.lds + MISC_OFF);
    F.tid = threadIdx.x; F.lane = F.tid & 63; F.wave = __builtin_amdgcn_readfirstlane(F.tid >> 6);
    F.G = gridDim.x; { const int bx = blockIdx.x; F.vcu = (F.G % 8 == 0) ? (bx % 8) * (F.G / 8) + bx / 8 : bx; }
    unsigned char* ws = args.ws; F.ws = ws; F.out = args.out;
    F.ctl = (gu32*)(ws + WS_CTL);
    for (int u = F.tid; u < (LDS_BYTES - LDSCTL_OFF) / 4; u += NWAVES * 64) ((LAS unsigned*)(F.lds + LDSCTL_OFF))[u] = 0u;
    __syncthreads();
    XcdBarrier bar; bar.bar = (unsigned*)(F.ctl + CW_BAR); bar.x = 0; bar.st = nullptr;
    if (!MK_SPLIT) bar = xcd_barrier_post((unsigned*)(F.ctl + CW_BAR), F.MISC + 8);
    const int lo = args.ph_lo, hi = args.ph_hi;
#ifndef PH_MASK
#define PH_MASK 0x7fff
#endif
#define IN(k) (((PH_MASK >> (k)) & 1) && lo <= (k) && (k) < hi)
#define SEAM(k) do { if (IN(k) && IN((k) + 1)) xcd_barrier(bar); } while (0)
    LAS unsigned char* ring = F.lds + RING_OFF;
    const int bx = (int)blockIdx.x;

    if (IN(0)) { p0_prologue(F); }
    SEAM(0);
    if (IN(1)) {
#pragma unroll
        for (int kv = 0; kv < 2; ++kv) { pg8::Gemm g{F.SC() + (size_t)kv * 65536 * 1024, F.CW1() + (size_t)kv * 256 * DM, DM, DM, 16}; pg8::StaticOrder S; S.init(256, 1, F.G, bx);
            EpiF32 E{F.HCS() + (size_t)kv * 65536 * 256, 256}; pg8::gemm_phase<EpiF32, pg8::StaticOrder, true, true>(ring, g, S, E); }
    }
    SEAM(1);
    if (IN(2)) { sk_ffn_in(F, F.XB() + (size_t)MP * DM, F.W1IN());
        pg8::Gemm g{F.XB(), F.W1IN(), DM, DM, 16}; pg8::StaticOrder S; S.init(128, 22, F.G, bx); EpiSwiglu E{F.ACT()}; pg8::gemm_phase<EpiSwiglu, pg8::StaticOrder, true, true>(ring, g, S, E); }
    SEAM(2);
    if (IN(3)) { sk_resid(F, F.ACT() + (size_t)MP * FF, FF, F.W1OUT(), FF, 22, F.xs(), ALPHA, 0.5f);
        pg8::Gemm g{F.ACT(), F.W1OUT(), FF, FF, 44}; pg8::StaticOrder S; S.init(128, 4, F.G, bx); EpiResid E{F.x(), F.PRE(), ALPHA, 0.5f}; pg8::gemm_phase<EpiResid, pg8::StaticOrder, true, true>(ring, g, S, E); }
    SEAM(3);
    if (IN(4)) ln_phase(F, F.PRE(), F.ln1g(), F.ln1b(), F.H(), F.H() + (size_t)MP * DM, F.HB());
    SEAM(4);
    if (IN(5)) { sk_proj(F);
        pg8::Gemm g{F.HB(), F.WIN(), DM, DM, 16}; pg8::StaticOrder S; S.init(128, 18, F.G, bx); EpiProj E{F.QB(), F.KVB(), F.UB(), F.VB(), F.SGA(), F.SGB(), F.GT(), F.out}; pg8::gemm_phase<EpiProj, pg8::StaticOrder, true, true>(ring, g, S, E); }
    SEAM(5);
    if (IN(6)) {
        for (int c = bx; c < MP / 128; c += F.G) gmlp_chunk(F, c);
        if (bx == F.G - 1) gmlp_sample(F);
        __syncthreads();
#pragma unroll
        for (int kv = 0; kv < 2; ++kv) { pg8::Gemm g{F.KVB() + (size_t)kv * KVB_T, F.CW1() + (size_t)kv * 256 * DM, DM, DM, 16}; pg8::StaticOrder S; S.init(16, 1, F.G, (bx + F.G - 32 - 16 * kv) % F.G);
            EpiF32 E{F.HCP() + (size_t)kv * 4096 * 256, 256}; pg8::gemm_phase<EpiF32, pg8::StaticOrder, true, true>(ring, g, S, E); }
    }
    SEAM(6);
    if (IN(7)) cmp2_phase(F);
    SEAM(7);
    if (IN(8)) {
#if ATTN_NAIVE
        attn_naive_phase(F, F.AZ());
#else
        attn_fast_phase(F);
#endif
#if ATTN_CHECK
        xcd_barrier(bar); attn_naive_phase(F, F.MB()); xcd_barrier(bar); attn_check_phase(F);
#endif
    }
    SEAM(8);
    if (IN(9)) { sk_merge(F);
        pg8::Gemm g{F.AZ(), F.WAB(), DM, DM, 16}; pg8::StaticOrder S; S.init(128, 4, F.G, bx); EpiMerge E{F.SGA(), F.SGB(), F.MB()}; pg8::gemm_phase<EpiMerge, pg8::StaticOrder, true, true>(ring, g, S, E); }
    SEAM(9);
    if (IN(10)) { sk_resid(F, F.MB() + (size_t)MP * DM, DM, F.WOUT(), DM, 8, F.H() + (size_t)MP * DM, ALPHA, 1.0f);
        pg8::Gemm g{F.MB(), F.WOUT(), DM, DM, 16}; pg8::StaticOrder S; S.init(128, 4, F.G, bx); EpiResid E{F.H(), F.PRE(), ALPHA, 1.0f}; pg8::gemm_phase<EpiResid, pg8::StaticOrder, true, true>(ring, g, S, E); }
    SEAM(10);
    if (IN(11)) ln_phase(F, F.PRE(), F.ln2g(), F.ln2b(), F.H(), F.H() + (size_t)MP * DM, F.HB());
    SEAM(11);
    if (IN(12)) { sk_ffn_in(F, F.HB() + (size_t)MP * DM, F.W2IN());
        pg8::Gemm g{F.HB(), F.W2IN(), DM, DM, 16}; pg8::StaticOrder S; S.init(128, 22, F.G, bx); EpiSwiglu E{F.ACT()}; pg8::gemm_phase<EpiSwiglu, pg8::StaticOrder, true, true>(ring, g, S, E); }
    SEAM(12);
    if (IN(13)) { sk_resid(F, F.ACT() + (size_t)MP * FF, FF, F.W2OUT(), FF, 22, F.H() + (size_t)MP * DM, ALPHA, 0.5f);
        pg8::Gemm g{F.ACT(), F.W2OUT(), FF, FF, 44}; pg8::StaticOrder S; S.init(128, 4, F.G, bx); EpiResid E{F.H(), F.PRE(), ALPHA, 0.5f}; pg8::gemm_phase<EpiResid, pg8::StaticOrder, true, true>(ring, g, S, E); }
    SEAM(13);
    if (IN(14)) { ln_phase(F, F.PRE(), F.ln3g(), F.ln3b(), F.out + O_Y, F.out + O_YS, nullptr);
#if ATTN_CHECK
        xcd_barrier(bar);
        if (bx == 0 && F.tid == 0) { const float* st = (const float*)(F.ctl + CW_STAT); const float v = __hip_atomic_load(st + (ATTN_CHECK - 1), RLX_AGENT);
            const float norm = (ATTN_CHECK == 1) ? (1.f / (MP * 2)) : (ATTN_CHECK == 2) ? (1.f / (MP * 2)) : (1.f / (MS * 2)); F.out[O_YS] += CHECK_GAIN * v * norm; }
#endif
    }
#undef IN
#undef SEAM
}

extern "C" void kernel_launch(void* const* d_in, const int* in_sizes, int n_in, void* d_out, int out_size, void* d_ws, size_t ws_size, hipStream_t stream) {
    static int grid = 0;
    if (grid == 0) {
        if (n_in != 33 || (size_t)out_size != O_END || ws_size < WS_END) { fprintf(stderr, "kernel_launch: unexpected shapes (n_in %d out %d ws %zu need %zu)\n", n_in, out_size, ws_size, (size_t)WS_END); grid = -1; return; }
        int dev = 0, cus = 0, per_cu = 0;
        if (hipGetDevice(&dev) != hipSuccess || hipDeviceGetAttribute(&cus, hipDeviceAttributeMultiprocessorCount, dev) != hipSuccess) { grid = -1; return; }
        if (hipFuncSetAttribute((const void*)nsa_fwd, hipFuncAttributeMaxDynamicSharedMemorySize, LDS_BYTES) != hipSuccess) { fprintf(stderr, "kernel_launch: hipFuncSetAttribute failed\n"); grid = -1; return; }
        if (hipOccupancyMaxActiveBlocksPerMultiprocessor(&per_cu, (const void*)nsa_fwd, NWAVES * 64, LDS_BYTES) != hipSuccess || per_cu < 1) { fprintf(stderr, "kernel_launch: occupancy query says %d\n", per_cu); }
        (void)hipGetLastError();
        grid = cus;
    }
    if (grid < 0) return;
    if (hipMemsetAsync((char*)d_ws + WS_CTL, 0, CTL_ZERO_BYTES, stream) != hipSuccess) return;
    Args a{};
    for (int i = 0; i < 33; ++i) a.in[i] = d_in[i];
    a.out = (float*)d_out; a.ws = (unsigned char*)d_ws;
#if MK_SPLIT
    for (int p = 0; p < N_PHASES; ++p) { a.ph_lo = p; a.ph_hi = p + 1; hipLaunchKernelGGL(nsa_fwd, dim3(grid), dim3(NWAVES * 64), LDS_BYTES, stream, a); }
#else
    a.ph_lo = 0; a.ph_hi = N_PHASES;
    hipLaunchKernelGGL(nsa_fwd, dim3(grid), dim3(NWAVES * 64), LDS_BYTES, stream, a);
#endif
}
```
